# Optimizing an MI355X kernel written in HIP

```python
import math
import jax, jax.numpy as jnp
from jax import lax
import numpy as np

D_MODEL = 1024
BATCH = 32
SEQ = 2048
DEPTH = 1

D_FF = 2816
CONV_WIDTH = 1024
CONV_HEADS = 16
CONV_K = 3
SSM_WIDTH = 512
SSM_GROUP = 16
SSM_GROUPS = SSM_WIDTH // SSM_GROUP
SSM_STATE = 64
DT_MIN = 0.001
DT_MAX = 0.1
N_MOD = 9
EPS = 1e-6
IN_COLS = 3 * CONV_WIDTH + SSM_WIDTH + 2 * D_MODEL

kernel_name = "hybrid_shortconv_s5_macaron_block"


def rms_norm(x, g):
    xf = x.astype(jnp.float32)
    y = xf * lax.rsqrt(jnp.mean(xf * xf, axis=-1, keepdims=True) + EPS)
    return (y * g.astype(jnp.float32)).astype(x.dtype)


def modulate(h, shift, scale):
    return h * (1.0 + scale[:, None, :]) + shift[:, None, :]


def swiglu(h, w1, w3, w2):
    return (jax.nn.silu(h @ w1) * (h @ w3)) @ w2


def short_conv(v, w):
    return lax.conv_general_dilated(
        v, w[:, None, :].astype(v.dtype), window_strides=(1,),
        padding=((CONV_K - 1, 0),),
        dimension_numbers=("NWC", "WIO", "NWC"),
        feature_group_count=v.shape[-1])


def s5_ssm(u, a_re, a_im, b_re, b_im, c_re, c_im, log_dt):
    bsz, seq, _ = u.shape
    f32 = jnp.float32
    uf = u.astype(f32).reshape(bsz, seq, SSM_GROUPS, SSM_GROUP).transpose(1, 0, 2, 3)
    lam = lax.complex(a_re.astype(f32), a_im.astype(f32))
    dt = jnp.exp(log_dt.astype(f32))[:, None]
    a_bar = jnp.exp(lam * dt)
    b_mat = lax.complex(b_re.astype(f32), b_im.astype(f32))
    b_bar = ((a_bar - 1.0) / lam)[..., None] * b_mat
    c_mat = lax.complex(c_re.astype(f32), c_im.astype(f32))
    bu = jnp.einsum("sbgh,gph->sbgp", uf.astype(jnp.complex64), b_bar)
    a_seq = jnp.broadcast_to(a_bar, (seq, 1) + a_bar.shape)

    def combine(left, right):
        a_l, b_l = left
        a_r, b_r = right
        return (a_r * a_l, a_r * b_l + b_r)

    _, states = lax.associative_scan(combine, (a_seq, bu), axis=0)
    y = jnp.einsum("sbgp,ghp->sbgh", states, c_mat).real
    return y.transpose(1, 0, 2, 3).reshape(bsz, seq, SSM_WIDTH)


def hybrid_mixer(h, w_in, conv_w, w_conv_out, a_re, a_im, b_re, b_im, c_re, c_im,
                 log_dt, d_skip, w_glu, w_ssm_out, w_out):
    proj = h @ w_in
    cuts = [CONV_WIDTH, 2 * CONV_WIDTH, 3 * CONV_WIDTH,
            3 * CONV_WIDTH + SSM_WIDTH, 3 * CONV_WIDTH + SSM_WIDTH + D_MODEL]
    gate_b, gate_c, v, u, glog_a, glog_b = jnp.split(proj, cuts, axis=-1)
    y_a = (gate_b * short_conv(gate_c * v, conv_w)) @ w_conv_out
    s = s5_ssm(u, a_re, a_im, b_re, b_im, c_re, c_im, log_dt).astype(u.dtype) + d_skip * u
    s = jax.nn.gelu(s)
    s = s * jax.nn.sigmoid(s @ w_glu)
    y_b = s @ w_ssm_out
    merged = jax.nn.sigmoid(glog_a) * y_a + jax.nn.sigmoid(glog_b) * y_b
    return merged @ w_out


def setup_inputs(seed: int = 0) -> dict:
    key = jax.random.key(seed)
    ks = jax.random.split(key, 32)
    L, D, G, P, H = DEPTH, D_MODEL, SSM_GROUPS, SSM_STATE, SSM_GROUP
    nrm = lambda k, shape, s: jax.random.normal(k, shape, jnp.float32) * s
    gain = lambda k: 1.0 + 0.02 * jax.random.normal(k, (L, D), jnp.float32)
    a_im_base = jnp.pi * jnp.arange(P, dtype=jnp.float32)
    return {
        "x": nrm(ks[0], (BATCH, SEQ, D), 1.0),
        "c": nrm(ks[1], (BATCH, D), 1.0),
        "w_ada": nrm(ks[2], (L, D, N_MOD * D), 0.5 * D ** -0.5),
        "b_ada": nrm(ks[3], (L, N_MOD * D), 0.01),
        "g_ffn1": gain(ks[4]),
        "w1_a": nrm(ks[5], (L, D, D_FF), D ** -0.5),
        "w3_a": nrm(ks[6], (L, D, D_FF), D ** -0.5),
        "w2_a": nrm(ks[7], (L, D_FF, D), D_FF ** -0.5),
        "g_mix": gain(ks[8]),
        "w_in": nrm(ks[9], (L, D, IN_COLS), D ** -0.5),
        "conv_w": nrm(ks[10], (L, CONV_K, CONV_WIDTH), CONV_K ** -0.5),
        "w_conv_out": nrm(ks[11], (L, CONV_WIDTH, D), CONV_WIDTH ** -0.5),
        "a_re": -0.5 + nrm(ks[12], (L, G, P), 0.01),
        "a_im": a_im_base + nrm(ks[13], (L, G, P), 0.01),
        "b_re": nrm(ks[14], (L, G, P, H), (2.0 * H) ** -0.5),
        "b_im": nrm(ks[15], (L, G, P, H), (2.0 * H) ** -0.5),
        "c_re": nrm(ks[16], (L, G, H, P), P ** -0.5),
        "c_im": nrm(ks[17], (L, G, H, P), P ** -0.5),
        "log_dt": jax.random.uniform(ks[18], (L, G), jnp.float32,
                                     math.log(DT_MIN), math.log(DT_MAX)),
        "d_skip": nrm(ks[19], (L, SSM_WIDTH), 1.0),
        "w_glu": nrm(ks[20], (L, SSM_WIDTH, SSM_WIDTH), SSM_WIDTH ** -0.5),
        "w_ssm_out": nrm(ks[21], (L, SSM_WIDTH, D), SSM_WIDTH ** -0.5),
        "w_out": nrm(ks[22], (L, D, D), D ** -0.5),
        "g_ffn2": gain(ks[23]),
        "w1_b": nrm(ks[24], (L, D, D_FF), D ** -0.5),
        "w3_b": nrm(ks[25], (L, D, D_FF), D ** -0.5),
        "w2_b": nrm(ks[26], (L, D_FF, D), D_FF ** -0.5),
        "g_final": 1.0 + 0.02 * jax.random.normal(ks[27], (D,), jnp.float32),
    }


def reference(x, c, w_ada, b_ada, g_ffn1, w1_a, w3_a, w2_a, g_mix, w_in, conv_w,
              w_conv_out, a_re, a_im, b_re, b_im, c_re, c_im, log_dt, d_skip, w_glu,
              w_ssm_out, w_out, g_ffn2, w1_b, w3_b, w2_b, g_final):
    cond = jax.nn.silu(c)
    for l in range(DEPTH):
        mod = cond @ w_ada[l] + b_ada[l]
        sh1, sc1, gt1, sh2, sc2, gt2, sh3, sc3, gt3 = jnp.split(mod, N_MOD, axis=-1)
        h = modulate(rms_norm(x, g_ffn1[l]), sh1, sc1)
        x = x + 0.5 * gt1[:, None, :] * swiglu(h, w1_a[l], w3_a[l], w2_a[l])
        h = modulate(rms_norm(x, g_mix[l]), sh2, sc2)
        x = x + gt2[:, None, :] * hybrid_mixer(
            h, w_in[l], conv_w[l], w_conv_out[l], a_re[l], a_im[l], b_re[l], b_im[l],
            c_re[l], c_im[l], log_dt[l], d_skip[l], w_glu[l], w_ssm_out[l], w_out[l])
        h = modulate(rms_norm(x, g_ffn2[l]), sh3, sc3)
        x = x + 0.5 * gt3[:, None, :] * swiglu(h, w1_b[l], w3_b[l], w2_b[l])
    return rms_norm(x, g_final)
```

```cpp
#include <hip/hip_runtime.h>
#include <hip/hip_cooperative_groups.h>
#include <cstdio>
#include <cstdint>
namespace cg = cooperative_groups;
namespace pg8 {
#define PG8_LAS __attribute__((address_space(3)))
typedef unsigned short bf16_t;
typedef short bf16x8 __attribute__((ext_vector_type(8)));
typedef float f32x4 __attribute__((ext_vector_type(4)));
typedef unsigned u32x4 __attribute__((ext_vector_type(4)));
constexpr int BM = 256, BK = 64, HALF = 128, HTB = HALF * BK * 2  , STAGE_BYTES = 8 * HTB, NXCD = 8, WGM = 8;

__host__ __device__ __forceinline__ int lds_byte(int r, int c) { const int st = (r >> 4) * 2 + (c >> 5), rr = r & 15, cc = c & 31, ob = rr * 64 + cc * 2; return st * 1024 + (ob ^ (((ob >> 9) & 1) << 5)); }
__host__ __device__ __forceinline__ void stage_rc(int b, int& R, int& C) { const int st = b / 1024, sb = b % 1024, swz = sb ^ (((sb >> 9) & 1) << 5); R = (st >> 1) * 16 + swz / 64; C = (st & 1) * 32 + (swz % 64) / 2; }
__host__ __device__ __forceinline__ int perm32(int rho) { const int n = rho >> 4, i = rho & 15; return 8 * (i >> 2) + 4 * n + (i & 3); }

struct Unit { int pm, pn; };
struct Gemm { const bf16_t* A; const bf16_t* Bt; int M, N, K; };

struct StaticOrder {
    int nM, nN, nwg, G, c;
    __host__ __device__ void init(int M, int N, int G_, int c_) { nM = M / BM; nN = N / BM; nwg = nM * nN; G = G_; c = c_; }
    __host__ __device__ bool next(int i, Unit& u) const {
        const long L = (long)i * G + c; if (L >= nwg) return false;
        int wgid = (int)L; { const int q = nwg / NXCD, r = nwg % NXCD, xcd = wgid % NXCD, off = wgid / NXCD; wgid = (xcd < r ? xcd * (q + 1) : r * (q + 1) + (xcd - r) * q) + off; }
        const int nig = WGM * nN, gid = wgid / nig, fm = gid * WGM, gsz = (nM - fm) < WGM ? (nM - fm) : WGM;
        u.pm = fm + ((wgid % nig) % gsz); u.pn = (wgid % nig) / gsz; return true;
    }
    __device__ __forceinline__ void a_ready(const Unit&) const {}
    __device__ __forceinline__ void done(const Unit&) const {}
};

__device__ __forceinline__ unsigned cvt_pk_bf16(float lo, float hi) { unsigned r; asm volatile("v_cvt_pk_bf16_f32 %0, %1, %2" : "=v"(r) : "v"(lo), "v"(hi)); return r; }
template <class Epi, class Sched, bool ALIGN_EPI = false, bool SP2 = false>
__device__ __forceinline__ void gemm_phase(PG8_LAS unsigned char* lds, const Gemm g, const Sched& S, const Epi& E) {
    const int tid = threadIdx.x, wid = __builtin_amdgcn_readfirstlane(tid >> 6), lane = tid & 63, wr = wid >> 2, wc = wid & 3, fr = lane & 15, fq = lane >> 4;
    const int K = g.K, nt = K / BK;
    unsigned voffA[2], voffB[2];
#pragma unroll
    for (int i = 0; i < 2; ++i) { int R, C; stage_rc(tid * 16 + i * 8192, R, C); const int Rb = Epi::PERM ? ((R & ~31) + perm32(R & 31)) : R;
        voffA[i] = (unsigned)(R * K + C) * 2u; voffB[i] = (unsigned)(Rb * K + C) * 2u; }
    const size_t kstep = (size_t)(BK * 2);
    const size_t hstep = (size_t)HALF * K * 2;
    const size_t tstep = 2 * hstep;
    const unsigned ldsw = (unsigned)wid * 1024u;
    const int aoff = lds_byte(wr * 64 + fr, fq * 8), boff = lds_byte(wc * 32 + fr, fq * 8);
#define PG8_SA(b, h) (((b) * 2 + (h)) * HTB)
#define PG8_SB(b, h) ((4 + (b) * 2 + (h)) * HTB)
#define PG8_STAGE(bufoff, gbase, voff) do { _Pragma("unroll") for (int _i = 0; _i < 2; ++_i) \
        __builtin_amdgcn_global_load_lds((const unsigned*)((const char*)(gbase) + (voff)[_i]), (PG8_LAS unsigned*)(lds + (bufoff) + ldsw + _i * 8192), 16, 0, 0); } while (0)
#define PG8_LDA(dst, b, h) do { _Pragma("unroll") for (int m = 0; m < 4; ++m) _Pragma("unroll") for (int k = 0; k < 2; ++k) dst[m][k] = *(const PG8_LAS bf16x8*)(lds + PG8_SA(b, h) + aoff + m * 2048 + k * 1024); } while (0)
#define PG8_LDB(dst, b, h) do { _Pragma("unroll") for (int n = 0; n < 2; ++n) _Pragma("unroll") for (int k = 0; k < 2; ++k) dst[n][k] = *(const PG8_LAS bf16x8*)(lds + PG8_SB(b, h) + boff + n * 2048 + k * 1024); } while (0)
#define PG8_MMA(ai, bj, At, Bt) do { __builtin_amdgcn_s_setprio(1); _Pragma("unroll") for (int m = 0; m < 4; ++m) _Pragma("unroll") for (int n = 0; n < 2; ++n) _Pragma("unroll") for (int k = 0; k < 2; ++k) \
        acc[ai][bj][m][n] = __builtin_amdgcn_mfma_f32_16x16x32_bf16(Bt[n][k], At[m][k], acc[ai][bj][m][n], 0, 0, 0); __builtin_amdgcn_s_setprio(0); } while (0)
#define PG8_WAIT_V(n) asm volatile("s_waitcnt vmcnt(" #n ")" ::: "memory")
#define PG8_WAIT_L(n) asm volatile("s_waitcnt lgkmcnt(" #n ")" ::: "memory")
#define PG8_BAR __builtin_amdgcn_s_barrier()
#define PG8_SCHED __builtin_amdgcn_sched_barrier(0)
    Unit cur, nxt; int ui = 0;
    if (!S.next(0, cur)) return;
    f32x4 acc[2][2][4][2];
#pragma unroll
    for (int a = 0; a < 2; ++a)
#pragma unroll
        for (int b = 0; b < 2; ++b)
#pragma unroll
            for (int m = 0; m < 4; ++m)
#pragma unroll
                for (int n = 0; n < 2; ++n) acc[a][b][m][n] = (f32x4){0.f, 0.f, 0.f, 0.f};
    bf16x8 At[4][2], B0[2][2], B1[2][2];
    const char* cA = (const char*)g.A + (size_t)cur.pm * tstep; const char* cB = (const char*)g.Bt + (size_t)cur.pn * tstep;
    S.a_ready(cur);
    if constexpr (SP2) {
        PG8_STAGE(PG8_SB(0, 0), cB, voffB); PG8_STAGE(PG8_SB(0, 1), cB + hstep, voffB); PG8_STAGE(PG8_SA(0, 0), cA, voffA); PG8_STAGE(PG8_SA(0, 1), cA + hstep, voffA);
        if (wr == 1) PG8_BAR;
        PG8_WAIT_V(2); PG8_BAR;
        PG8_STAGE(PG8_SB(1, 0), cB + kstep, voffB); PG8_STAGE(PG8_SA(1, 0), cA + kstep, voffA); PG8_STAGE(PG8_SB(1, 1), cB + hstep + kstep, voffB);
        PG8_WAIT_V(6); PG8_BAR;
    } else {
        PG8_STAGE(PG8_SB(0, 0), cB, voffB); PG8_STAGE(PG8_SA(0, 0), cA, voffA); PG8_STAGE(PG8_SB(0, 1), cB + hstep, voffB); PG8_STAGE(PG8_SA(0, 1), cA + hstep, voffA);
        if (wr == 1) PG8_BAR;
        PG8_WAIT_V(4); PG8_BAR;
        PG8_STAGE(PG8_SB(1, 0), cB + kstep, voffB); PG8_STAGE(PG8_SA(1, 0), cA + kstep, voffA); PG8_STAGE(PG8_SB(1, 1), cB + hstep + kstep, voffB);
        PG8_WAIT_V(6); PG8_BAR;
    }
    for (;;) {
        const bool has_next = S.next(ui + 1, nxt);
        const char* nA = has_next ? (const char*)g.A + (size_t)nxt.pm * tstep : cA; const char* nB = has_next ? (const char*)g.Bt + (size_t)nxt.pn * tstep : cB;
        for (int t = 0; t < nt; t += 2) {
            const bool last = (t == nt - 2);
            const char* a1 = cA + (size_t)(t + 1) * kstep;
            const char* a2 = last ? nA : cA + (size_t)(t + 2) * kstep; const char* b2 = last ? nB : cB + (size_t)(t + 2) * kstep;
            const char* a3 = a2 + kstep; const char* b3 = b2 + kstep;
            if (last && has_next) S.a_ready(nxt);
            if constexpr (SP2) {
            PG8_LDB(B0, 0, 0); PG8_LDB(B1, 0, 1); PG8_SCHED; PG8_LDA(At, 0, 0); PG8_STAGE(PG8_SA(1, 1), a1 + hstep, voffA);
            PG8_WAIT_V(8); PG8_WAIT_L(0); PG8_BAR; PG8_MMA(0, 0, At, B0); PG8_MMA(0, 1, At, B1); PG8_BAR; PG8_SCHED;
            PG8_LDA(At, 0, 1); PG8_STAGE(PG8_SB(0, 0), b2, voffB); PG8_STAGE(PG8_SB(0, 1), b2 + hstep, voffB); PG8_STAGE(PG8_SA(0, 0), a2, voffA);
            PG8_WAIT_V(8); PG8_WAIT_L(0); PG8_BAR; PG8_MMA(1, 0, At, B0); PG8_MMA(1, 1, At, B1); PG8_BAR; PG8_SCHED;
            PG8_LDB(B0, 1, 0); PG8_LDB(B1, 1, 1); PG8_SCHED; PG8_LDA(At, 1, 0); PG8_STAGE(PG8_SA(0, 1), a2 + hstep, voffA);
            PG8_WAIT_V(8); PG8_WAIT_L(0); PG8_BAR; PG8_MMA(0, 0, At, B0); PG8_MMA(0, 1, At, B1); PG8_BAR; PG8_SCHED;
            PG8_LDA(At, 1, 1); PG8_STAGE(PG8_SB(1, 0), b3, voffB); PG8_STAGE(PG8_SB(1, 1), b3 + hstep, voffB); PG8_STAGE(PG8_SA(1, 0), a3, voffA);
            PG8_WAIT_V(8); PG8_WAIT_L(0); PG8_BAR; PG8_MMA(1, 0, At, B0); PG8_MMA(1, 1, At, B1); PG8_BAR; PG8_SCHED;
            } else {
            PG8_LDB(B0, 0, 0); PG8_SCHED; PG8_LDA(At, 0, 0); PG8_STAGE(PG8_SA(1, 1), a1 + hstep, voffA);
            PG8_WAIT_L(8); PG8_BAR; PG8_WAIT_L(0); PG8_MMA(0, 0, At, B0); PG8_BAR; PG8_SCHED;
            PG8_LDB(B1, 0, 1); PG8_STAGE(PG8_SB(0, 0), b2, voffB);
            PG8_BAR; PG8_WAIT_L(0); PG8_MMA(0, 1, At, B1); PG8_BAR;
            PG8_LDA(At, 0, 1); PG8_STAGE(PG8_SA(0, 0), a2, voffA);
            PG8_BAR; PG8_WAIT_L(0); PG8_MMA(1, 0, At, B0); PG8_BAR; PG8_SCHED;
            PG8_STAGE(PG8_SB(0, 1), b2 + hstep, voffB);
            PG8_WAIT_V(6); PG8_BAR; PG8_MMA(1, 1, At, B1); PG8_BAR;
            PG8_LDB(B0, 1, 0); PG8_SCHED; PG8_LDA(At, 1, 0); PG8_STAGE(PG8_SA(0, 1), a2 + hstep, voffA);
            PG8_WAIT_L(8); PG8_BAR; PG8_WAIT_L(0); PG8_MMA(0, 0, At, B0); PG8_BAR; PG8_SCHED;
            PG8_LDB(B1, 1, 1); PG8_STAGE(PG8_SB(1, 0), b3, voffB);
            PG8_BAR; PG8_WAIT_L(0); PG8_MMA(0, 1, At, B1); PG8_BAR;
            PG8_LDA(At, 1, 1); PG8_STAGE(PG8_SA(1, 0), a3, voffA);
            PG8_BAR; PG8_WAIT_L(0); PG8_MMA(1, 0, At, B0); PG8_BAR; PG8_SCHED;
            PG8_STAGE(PG8_SB(1, 1), b3 + hstep, voffB);
            PG8_WAIT_V(6); PG8_BAR; PG8_MMA(1, 1, At, B1); PG8_BAR;
            }
        }
        if constexpr (ALIGN_EPI) { if (wr == 0) PG8_BAR; }
        if constexpr (!Epi::AFTER_DRAIN) { E(acc, cur, wr, wc, fr, fq); S.done(cur); }
        if (!has_next) break;
#pragma unroll
        for (int a = 0; a < 2; ++a)
#pragma unroll
            for (int b = 0; b < 2; ++b)
#pragma unroll
                for (int m = 0; m < 4; ++m)
#pragma unroll
                    for (int n = 0; n < 2; ++n) acc[a][b][m][n] = (f32x4){0.f, 0.f, 0.f, 0.f};
        cur = nxt; cA = nA; cB = nB; ++ui;
        if constexpr (ALIGN_EPI) { if (wr == 1) PG8_BAR; }
    }
    PG8_WAIT_V(0);
    if constexpr (!ALIGN_EPI) { if (wr == 0) PG8_BAR; }
    PG8_BAR;
    if constexpr (Epi::AFTER_DRAIN) { E.fused(acc, cur, wr, wc, fr, fq, lds, wid, lane); S.done(cur); }
#undef PG8_SA
#undef PG8_SB
#undef PG8_STAGE
#undef PG8_LDA
#undef PG8_LDB
#undef PG8_MMA
#undef PG8_WAIT_V
#undef PG8_WAIT_L
#undef PG8_BAR
#undef PG8_SCHED
}
}

constexpr int BATCH = 32, SEQ = 2048, D = 1024, M = BATCH * SEQ, FF = 2816, NUP = 2 * FF, NIN = 5632;
constexpr int SW = 512, NMODC = 9 * D;
constexpr float EPS = 1e-6f;
constexpr int NWAVES = 8, NTHR = 512;
constexpr int LDS_BYTES = 147456;
constexpr size_t MiB = 1u << 20;
constexpr size_t WS_MOD = 1 * MiB, WS_ABAR = 3 * MiB, WS_BMAT = 3 * MiB + 64 * 1024, WS_CMAT = 3 * MiB + 256 * 1024;
constexpr size_t WS_WUPA = 4 * MiB, WS_WDNA = 15 * MiB, WS_WIN = 21 * MiB, WS_WC = 32 * MiB, WS_WG = 34 * MiB, WS_WS = 35 * MiB, WS_WO = 36 * MiB, WS_WUPB = 38 * MiB, WS_WDNB = 49 * MiB;
constexpr size_t WS_X1 = 56 * MiB, WS_XN = 312 * MiB, WS_S = 312 * MiB, WS_S2 = 376 * MiB, WS_HB = 440 * MiB, WS_U = 440 * MiB, WS_SA = 504 * MiB, WS_SB = 632 * MiB, WS_END = 792 * MiB;

#define LAS __attribute__((address_space(3)))
typedef unsigned short bf16;
typedef unsigned u32x4 __attribute__((ext_vector_type(4)));
typedef unsigned u32x2 __attribute__((ext_vector_type(2)));
typedef float f32x4 __attribute__((ext_vector_type(4)));
typedef float f32x2 __attribute__((ext_vector_type(2)));
typedef float f32x16 __attribute__((ext_vector_type(16)));
typedef short bf16x8 __attribute__((ext_vector_type(8)));
#define LDS_WAIT() asm volatile("s_waitcnt lgkmcnt(0)" ::: "memory")

__device__ __forceinline__ unsigned pk2(float lo, float hi) { return pg8::cvt_pk_bf16(lo, hi); }
__device__ __forceinline__ float bflo(unsigned w) { return __uint_as_float(w << 16); }
__device__ __forceinline__ float bfhi(unsigned w) { return __uint_as_float(w & 0xffff0000u); }
__device__ __forceinline__ float bf2f(bf16 v) { return __uint_as_float((unsigned)v << 16); }
__device__ __forceinline__ float fsigmoid(float x) { return __builtin_amdgcn_rcpf(1.0f + __builtin_amdgcn_exp2f(-1.44269504f * x)); }
__device__ __forceinline__ float fsilu(float x) { return x * fsigmoid(x); }
__device__ __forceinline__ float fgelu_tanh(float x) { const float u = x + 0.044715f * x * x * x; return x * __builtin_amdgcn_rcpf(1.0f + __builtin_amdgcn_exp2f(-2.0f * 0.7978845608f * 1.44269504f * u)); }
__device__ __forceinline__ void unpack8(const u32x4 w, float (&f)[8]) { f[0] = bflo(w.x); f[1] = bfhi(w.x); f[2] = bflo(w.y); f[3] = bfhi(w.y); f[4] = bflo(w.z); f[5] = bfhi(w.z); f[6] = bflo(w.w); f[7] = bfhi(w.w); }
__device__ __forceinline__ u32x4 pack8(const float (&f)[8]) { u32x4 w; w.x = pk2(f[0], f[1]); w.y = pk2(f[2], f[3]); w.z = pk2(f[4], f[5]); w.w = pk2(f[6], f[7]); return w; }
__device__ __forceinline__ float wave_sum(float v) {
#pragma unroll
    for (int o = 1; o < 64; o <<= 1) v += __shfl_xor(v, o);
    return v;
}

enum { EM_SWIGLU = 0, EM_RES = 1, EM_WIN = 2, EM_MULA = 3, EM_GLU = 4, EM_MERGE = 5 };
struct Epi {
    static constexpr bool PERM = true, AFTER_DRAIN = false;
    int mode;
    bf16* O; int ldc;
    bf16 *O2, *O3, *O4, *O5;
    const bf16* P; const bf16* Q;
    const float* base; float* outf; const float* gate; float coef;
    __device__ __forceinline__ void operator()(const f32x4 (&acc)[2][2][4][2], const pg8::Unit& u, int wr, int wc, int fr, int fq) const {
        const int row0 = u.pm * 256 + wr * 64 + fr;
        const int cw = wc * 32 + 8 * fq;
        if (mode == EM_SWIGLU) {
            bf16* bp = O + (size_t)row0 * ldc + u.pn * 128 + cw;
#pragma unroll
            for (int ai = 0; ai < 2; ++ai)
#pragma unroll
                for (int m = 0; m < 4; ++m) {
                    float o[8];
#pragma unroll
                    for (int n = 0; n < 2; ++n)
#pragma unroll
                        for (int j = 0; j < 4; ++j) o[4 * n + j] = fsilu(acc[ai][0][m][n][j]) * acc[ai][1][m][n][j];
                    *(u32x4*)(bp + (size_t)(ai * 128 + m * 16) * ldc) = pack8(o);
                }
        } else if (mode == EM_RES) {
            const int b = u.pm >> 3;
            const float* gp = gate + (size_t)b * NMODC + u.pn * 256 + cw;
            f32x4 gv[2][2];
#pragma unroll
            for (int bj = 0; bj < 2; ++bj)
#pragma unroll
                for (int n = 0; n < 2; ++n) gv[bj][n] = *(const f32x4*)(gp + bj * 128 + 4 * n) * coef;
#pragma unroll
            for (int ai = 0; ai < 2; ++ai)
#pragma unroll
                for (int m = 0; m < 4; ++m) {
                    const size_t off = (size_t)(row0 + ai * 128 + m * 16) * D + u.pn * 256 + cw;
#pragma unroll
                    for (int bj = 0; bj < 2; ++bj)
#pragma unroll
                        for (int n = 0; n < 2; ++n) {
                            const f32x4 bs = *(const f32x4*)(base + off + bj * 128 + 4 * n);
                            *(f32x4*)(outf + off + bj * 128 + 4 * n) = bs + gv[bj][n] * acc[ai][bj][m][n];
                        }
                    if (m & 1) asm volatile("" ::: "memory");
                }
        } else if (mode == EM_WIN) {
            const int pn = u.pn;
            if (pn >= 4 && pn < 12) {
                bf16* bp = O2 + (size_t)row0 * D + (pn - 4) * 128 + cw;
#pragma unroll
                for (int ai = 0; ai < 2; ++ai)
#pragma unroll
                    for (int m = 0; m < 4; ++m) {
                        float o[8];
#pragma unroll
                        for (int n = 0; n < 2; ++n)
#pragma unroll
                            for (int j = 0; j < 4; ++j) o[4 * n + j] = acc[ai][0][m][n][j] * acc[ai][1][m][n][j];
                        *(u32x4*)(bp + (size_t)(ai * 128 + m * 16) * D) = pack8(o);
                    }
            } else {
                bf16* dst; int ld, colt; bool sig;
                if (pn < 4) { dst = O; ld = D; colt = pn * 256; sig = false; }
                else if (pn < 14) { dst = O3; ld = SW; colt = (pn - 12) * 256; sig = false; }
                else if (pn < 18) { dst = O4; ld = D; colt = (pn - 14) * 256; sig = true; }
                else { dst = O5; ld = D; colt = (pn - 18) * 256; sig = true; }
                bf16* bp = dst + (size_t)row0 * ld + colt + cw;
#pragma unroll
                for (int ai = 0; ai < 2; ++ai)
#pragma unroll
                    for (int m = 0; m < 4; ++m)
#pragma unroll
                        for (int bj = 0; bj < 2; ++bj) {
                            float o[8];
#pragma unroll
                            for (int n = 0; n < 2; ++n)
#pragma unroll
                                for (int j = 0; j < 4; ++j) { const float v = acc[ai][bj][m][n][j]; o[4 * n + j] = sig ? fsigmoid(v) : v; }
                            *(u32x4*)(bp + (size_t)(ai * 128 + m * 16) * ld + bj * 128) = pack8(o);
                        }
            }
        } else {
            const size_t off0 = (size_t)row0 * ldc + u.pn * 256 + cw;
#pragma unroll
            for (int ai = 0; ai < 2; ++ai)
#pragma unroll
                for (int m = 0; m < 4; ++m) {
#pragma unroll
                    for (int bj = 0; bj < 2; ++bj) {
                        const size_t off = off0 + (size_t)(ai * 128 + m * 16) * ldc + bj * 128;
                        float p[8], q[8], o[8];
                        unpack8(*(const u32x4*)(P + off), p);
                        if (mode == EM_MERGE) unpack8(*(const u32x4*)(Q + off), q);
#pragma unroll
                        for (int n = 0; n < 2; ++n)
#pragma unroll
                            for (int j = 0; j < 4; ++j) {
                                const float v = acc[ai][bj][m][n][j];
                                o[4 * n + j] = (mode == EM_MULA) ? p[4 * n + j] * v : (mode == EM_GLU) ? p[4 * n + j] * fsigmoid(v) : p[4 * n + j] + q[4 * n + j] * v;
                            }
                        *(u32x4*)(O + off) = pack8(o);
                    }
                    if (m & 1) asm volatile("" ::: "memory");
                }
        }
    }
};

__device__ __forceinline__ void tr_item(const float* W, int K, int N, int k0, int n0, bf16* WT, int drow0, LAS float* scr, int lane) {
#pragma unroll 8
    for (int i = 0; i < 32; ++i) { const int kk = 2 * i + (lane >> 5); scr[kk * 33 + (lane & 31)] = W[(size_t)(k0 + kk) * N + n0 + (lane & 31)]; }
    LDS_WAIT();
    const int c = lane & 7;
#pragma unroll
    for (int j = 0; j < 4; ++j) {
        const int n = (lane >> 3) + 8 * j; const LAS float* s = scr + (8 * c) * 33 + n;
        u32x4 o; o.x = pk2(s[0 * 33], s[1 * 33]); o.y = pk2(s[2 * 33], s[3 * 33]); o.z = pk2(s[4 * 33], s[5 * 33]); o.w = pk2(s[6 * 33], s[7 * 33]);
        *(u32x4*)(WT + (size_t)(drow0 + n) * K + k0 + 8 * c) = o;
    }
    LDS_WAIT();
}
enum { MAP_PLAIN = 0, MAP_UP1 = 1, MAP_UP3 = 2, MAP_WIN = 3 };
__device__ __forceinline__ int map_row(int map, int n0) {
    if (map == MAP_PLAIN) return n0;
    if (map == MAP_UP1) return 256 * (n0 >> 7) + (n0 & 127);
    if (map == MAP_UP3) return 256 * (n0 >> 7) + 128 + (n0 & 127);
    if (n0 < 1024 || n0 >= 3072) return n0;
    if (n0 < 2048) { const int cc = n0 - 1024; return 1024 + 256 * (cc >> 7) + (cc & 127); }
    { const int cc = n0 - 2048; return 1024 + 256 * (cc >> 7) + 128 + (cc & 127); }
}

struct Args { const float* in[28]; float* out; unsigned char* ws; int ph_lo, ph_hi; };

__device__ __forceinline__ void prologue(const Args& a, LAS unsigned char* lds, int tid, int lane, int wave, int bid, int G) {
    unsigned char* ws = a.ws;
    for (int job = bid; job < NMODC / 32; job += G) {
        const int n0 = job * 32, l31 = lane & 31, h5 = lane >> 5;
        f32x16 acc;
#pragma unroll
        for (int r = 0; r < 16; ++r) acc[r] = 0.f;
        const float* cp = a.in[1] + (size_t)l31 * D + wave * 128 + 8 * h5;
        const float* wp = a.in[2] + (size_t)(wave * 128 + 8 * h5) * NMODC + n0 + l31;
#pragma unroll
        for (int kk = 0; kk < 8; ++kk) {
            const f32x4 c0 = *(const f32x4*)(cp + 16 * kk), c1 = *(const f32x4*)(cp + 16 * kk + 4);
            float wv[8];
#pragma unroll
            for (int j = 0; j < 8; ++j) wv[j] = wp[(size_t)(16 * kk + j) * NMODC];
            u32x4 ua, ub;
            ua.x = pk2(c0.x / (1.0f + __expf(-c0.x)), c0.y / (1.0f + __expf(-c0.y))); ua.y = pk2(c0.z / (1.0f + __expf(-c0.z)), c0.w / (1.0f + __expf(-c0.w)));
            ua.z = pk2(c1.x / (1.0f + __expf(-c1.x)), c1.y / (1.0f + __expf(-c1.y))); ua.w = pk2(c1.z / (1.0f + __expf(-c1.z)), c1.w / (1.0f + __expf(-c1.w)));
            ub.x = pk2(wv[0], wv[1]); ub.y = pk2(wv[2], wv[3]); ub.z = pk2(wv[4], wv[5]); ub.w = pk2(wv[6], wv[7]);
            acc = __builtin_amdgcn_mfma_f32_32x32x16_bf16(__builtin_bit_cast(bf16x8, ua), __builtin_bit_cast(bf16x8, ub), acc, 0, 0, 0);
        }
        LAS float* part = (LAS float*)lds;
#pragma unroll
        for (int r = 0; r < 16; ++r) part[(wave * 32 + (r & 3) + 8 * (r >> 2) + 4 * h5) * 32 + l31] = acc[r];
        __syncthreads();
        float* mod = (float*)(ws + WS_MOD);
        for (int o = tid; o < 1024; o += NTHR) {
            const int b = o >> 5, n = o & 31; float sacc = a.in[3][n0 + n];
#pragma unroll
            for (int w8 = 0; w8 < 8; ++w8) sacc += part[(w8 * 32 + b) * 32 + n];
            mod[(size_t)b * NMODC + n0 + n] = sacc;
        }
        __syncthreads();
    }
    if (bid >= G - 4) {
        const int g = (bid - (G - 4)) * 8 + wave, p = lane;
        const float dt = expf(a.in[18][g]);
        const float ar = a.in[12][g * 64 + p], ai = a.in[13][g * 64 + p];
        const float e = expf(ar * dt); float sn, cs; sincosf(ai * dt, &sn, &cs);
        const float abr = e * cs, abi = e * sn;
        const float nr = abr - 1.0f, ni = abi, den = ar * ar + ai * ai;
        const float cr = (nr * ar + ni * ai) / den, ci = (ni * ar - nr * ai) / den;
        float* abar = (float*)(ws + WS_ABAR);
        abar[2 * (g * 64 + p)] = abr; abar[2 * (g * 64 + p) + 1] = abi;
        bf16* Bm = (bf16*)(ws + WS_BMAT);
        unsigned* Cm = (unsigned*)(ws + WS_CMAT);
        float re[16], im[16];
#pragma unroll
        for (int h = 0; h < 16; ++h) { const float br = a.in[14][(size_t)(g * 64 + p) * 16 + h], bi = a.in[15][(size_t)(g * 64 + p) * 16 + h]; re[h] = cr * br - ci * bi; im[h] = cr * bi + ci * br; }
        u32x4* d0 = (u32x4*)(Bm + (size_t)(g * 128 + 2 * p) * 16);
        { u32x4 w0, w1, w2, w3;
          w0.x = pk2(re[0], re[1]); w0.y = pk2(re[2], re[3]); w0.z = pk2(re[4], re[5]); w0.w = pk2(re[6], re[7]);
          w1.x = pk2(re[8], re[9]); w1.y = pk2(re[10], re[11]); w1.z = pk2(re[12], re[13]); w1.w = pk2(re[14], re[15]);
          w2.x = pk2(im[0], im[1]); w2.y = pk2(im[2], im[3]); w2.z = pk2(im[4], im[5]); w2.w = pk2(im[6], im[7]);
          w3.x = pk2(im[8], im[9]); w3.y = pk2(im[10], im[11]); w3.z = pk2(im[12], im[13]); w3.w = pk2(im[14], im[15]);
          d0[0] = w0; d0[1] = w1; d0[2] = w2; d0[3] = w3; }
#pragma unroll
        for (int h = 0; h < 16; ++h) Cm[(size_t)(g * 16 + h) * 64 + p] = pk2(a.in[16][(size_t)(g * 16 + h) * 64 + p], -a.in[17][(size_t)(g * 16 + h) * 64 + p]);
    }
    LAS float* scr = (LAS float*)(lds + wave * 16384);
    const int gw = bid * NWAVES + wave, NGW = G * NWAVES;
#define TRJ(idx, K_, N_, wsoff, MAP_) if (!found) { constexpr int items = ((K_) / 64) * ((N_) / 32); if (r < items) { found = true; W = a.in[idx]; K = (K_); N = (N_); WT = (bf16*)(ws + (wsoff)); map = (MAP_); } else r -= items; }
    constexpr int NITEMS = 2 * (3 * (D / 64) * (FF / 32)) + (D / 64) * (NIN / 32) + 2 * (D / 64) * (D / 32) + (SW / 64) * (SW / 32) + (SW / 64) * (D / 32);
#pragma unroll 1
    for (int it = gw; it < NITEMS; it += NGW) {
        int r = it; bool found = false; const float* W = nullptr; int K = 64, N = 32, map = 0; bf16* WT = nullptr;
        TRJ(5, D, FF, WS_WUPA, MAP_UP1)
        TRJ(6, D, FF, WS_WUPA, MAP_UP3)
        TRJ(7, FF, D, WS_WDNA, MAP_PLAIN)
        TRJ(9, D, NIN, WS_WIN, MAP_WIN)
        TRJ(11, D, D, WS_WC, MAP_PLAIN)
        TRJ(20, SW, SW, WS_WG, MAP_PLAIN)
        TRJ(21, SW, D, WS_WS, MAP_PLAIN)
        TRJ(22, D, D, WS_WO, MAP_PLAIN)
        TRJ(24, D, FF, WS_WUPB, MAP_UP1)
        TRJ(25, D, FF, WS_WUPB, MAP_UP3)
        TRJ(26, FF, D, WS_WDNB, MAP_PLAIN)
        const int nbn = N / 32, kb = r / nbn, nb = r % nbn;
        tr_item(W, K, N, 64 * kb, 32 * nb, WT, map_row(map, 32 * nb), scr, lane);
    }
#undef TRJ
}

__device__ __forceinline__ void norm_phase(const float* X, const float* gvec, const float* modsh, const float* modsc, bf16* outb, float* outf, int gw, int NGW, int lane) {
    for (int r0 = gw * 32; r0 < M; r0 += NGW * 32) {
        const int b = r0 / SEQ;
        f32x4 scl[4], sft[4];
#pragma unroll
        for (int j = 0; j < 4; ++j) {
            const f32x4 gg = *(const f32x4*)(gvec + 4 * lane + 256 * j);
            if (modsh) { const f32x4 s1 = *(const f32x4*)(modsc + (size_t)b * NMODC + 4 * lane + 256 * j); scl[j] = gg * (s1 + 1.0f); sft[j] = *(const f32x4*)(modsh + (size_t)b * NMODC + 4 * lane + 256 * j); }
            else { scl[j] = gg; sft[j] = (f32x4){0.f, 0.f, 0.f, 0.f}; }
        }
#pragma unroll 1
        for (int rr = 0; rr < 32; rr += 4) {
            asm volatile("" ::: "memory");
            f32x4 v[4][4];
#pragma unroll
            for (int q = 0; q < 4; ++q)
#pragma unroll
                for (int j = 0; j < 4; ++j) v[q][j] = *(const f32x4*)(X + (size_t)(r0 + rr + q) * D + 4 * lane + 256 * j);
#pragma unroll
            for (int q = 0; q < 4; ++q) {
                float s = 0.f;
#pragma unroll
                for (int j = 0; j < 4; ++j) s += (v[q][j].x * v[q][j].x + v[q][j].y * v[q][j].y) + (v[q][j].z * v[q][j].z + v[q][j].w * v[q][j].w);
                s = wave_sum(s);
                const float rstd = 1.0f / sqrtf(s * (1.0f / D) + EPS);
                const size_t ro = (size_t)(r0 + rr + q) * D + 4 * lane;
#pragma unroll
                for (int j = 0; j < 4; ++j) {
                    const f32x4 o = v[q][j] * rstd * scl[j] + sft[j];
                    if (outb) { u32x2 w; w.x = pk2(o.x, o.y); w.y = pk2(o.z, o.w); *(u32x2*)(outb + ro + 256 * j) = w; }
                    else *(f32x4*)(outf + ro + 256 * j) = o;
                }
            }
        }
    }
}

__device__ __forceinline__ void ssm_job(int job, LAS unsigned char* wl, const bf16* U, bf16* S, const float* abar, const bf16* Bmat, const bf16* CmT, const float* dskip, int lane) {
    const int b = job >> 5, g = job & 31;
    const int l31 = lane & 31, h5 = lane >> 5, l15 = lane & 15, q4 = lane >> 4;
    bf16x8 Bf[4], Cf[4];
#pragma unroll
    for (int nb = 0; nb < 4; ++nb) Bf[nb] = *(const bf16x8*)(Bmat + ((size_t)(g * 128 + 32 * nb + l31) * 16 + 8 * h5));
#pragma unroll
    for (int kb = 0; kb < 4; ++kb) Cf[kb] = *(const bf16x8*)(CmT + ((size_t)(g * 16 + l15) * 128 + 32 * kb + 8 * q4));
    const f32x2 ab = *(const f32x2*)(abar + 2 * (g * 64 + lane));
    const float dsk = dskip[16 * g + l15];
    float xr = 0.f, xi = 0.f;
    LAS float* Bu = (LAS float*)wl;
    LAS unsigned* Xs = (LAS unsigned*)(wl + 16384);
    const bf16* Ub = U + (size_t)b * SEQ * SW + 16 * g;
    bf16* Sb = S + (size_t)b * SEQ * SW + 16 * g;
    bf16x8 Af = *(const bf16x8*)(Ub + (size_t)l31 * SW + 8 * h5);
    for (int ch = 0; ch < SEQ / 32; ++ch) {
        const int t0 = ch * 32;
        bf16x8 Afn = Af;
        if (ch + 1 < SEQ / 32) Afn = *(const bf16x8*)(Ub + (size_t)(t0 + 32 + l31) * SW + 8 * h5);
        bf16 uu[2][4];
#pragma unroll
        for (int mb = 0; mb < 2; ++mb)
#pragma unroll
            for (int r = 0; r < 4; ++r) uu[mb][r] = Ub[(size_t)(t0 + 16 * mb + 4 * q4 + r) * SW + l15];
#pragma unroll
        for (int nb = 0; nb < 4; ++nb) {
            f32x16 c;
#pragma unroll
            for (int r = 0; r < 16; ++r) c[r] = 0.f;
            c = __builtin_amdgcn_mfma_f32_32x32x16_bf16(Af, Bf[nb], c, 0, 0, 0);
#pragma unroll
            for (int r = 0; r < 16; ++r) Bu[((r & 3) + 8 * (r >> 2) + 4 * h5) * 128 + 32 * nb + l31] = c[r];
        }
        LDS_WAIT();
#pragma unroll 8
        for (int t = 0; t < 32; ++t) {
            const f32x2 bu = *(const LAS f32x2*)(Bu + t * 128 + 2 * lane);
            const float nr = __builtin_fmaf(ab.x, xr, __builtin_fmaf(-ab.y, xi, bu.x));
            const float ni = __builtin_fmaf(ab.x, xi, __builtin_fmaf(ab.y, xr, bu.y));
            xr = nr; xi = ni;
            Xs[t * 68 + lane] = pk2(nr, ni);
        }
        LDS_WAIT();
        f32x4 y[2];
#pragma unroll
        for (int mb = 0; mb < 2; ++mb) {
            y[mb] = (f32x4){0.f, 0.f, 0.f, 0.f};
#pragma unroll
            for (int kb = 0; kb < 4; ++kb) {
                const bf16x8 xa = *(const LAS bf16x8*)((const LAS unsigned char*)Xs + (16 * mb + l15) * 272 + (32 * kb + 8 * q4) * 2);
                y[mb] = __builtin_amdgcn_mfma_f32_16x16x32_bf16(xa, Cf[kb], y[mb], 0, 0, 0);
            }
        }
#pragma unroll
        for (int mb = 0; mb < 2; ++mb)
#pragma unroll
            for (int r = 0; r < 4; ++r) {
                const float s = y[mb][r] + dsk * bf2f(uu[mb][r]);
                Sb[(size_t)(t0 + 16 * mb + 4 * q4 + r) * SW + l15] = (bf16)(pk2(fgelu_tanh(s), 0.f) & 0xffffu);
            }
        LDS_WAIT();
        Af = Afn;
    }
}

__device__ __forceinline__ void conv_job(int j, const bf16* Z, bf16* GB, const float* cwt, int lane) {
    const int b = j >> 7, rem = j & 127, tb = rem >> 1, half = rem & 1;
    const int col = half * 512 + lane * 8;
    float w0[8], w1[8], w2[8];
#pragma unroll
    for (int i = 0; i < 8; ++i) { w0[i] = cwt[col + i]; w1[i] = cwt[D + col + i]; w2[i] = cwt[2 * D + col + i]; }
    const size_t rowbase = (size_t)b * SEQ + tb * 32;
    float z2[8], z1[8];
#pragma unroll
    for (int i = 0; i < 8; ++i) { z2[i] = 0.f; z1[i] = 0.f; }
    if (tb > 0) { unpack8(*(const u32x4*)(Z + (rowbase - 2) * D + col), z2); unpack8(*(const u32x4*)(Z + (rowbase - 1) * D + col), z1); }
#pragma unroll 4
    for (int t = 0; t < 32; ++t) {
        float zc[8], gb[8], o[8];
        unpack8(*(const u32x4*)(Z + (rowbase + t) * D + col), zc);
        unpack8(*(const u32x4*)(GB + (rowbase + t) * D + col), gb);
#pragma unroll
        for (int i = 0; i < 8; ++i) { o[i] = gb[i] * (w0[i] * z2[i] + w1[i] * z1[i] + w2[i] * zc[i]); z2[i] = z1[i]; z1[i] = zc[i]; }
        *(u32x4*)(GB + (rowbase + t) * D + col) = pack8(o);
    }
}

constexpr int NPH = 15;
__global__ void __launch_bounds__(NTHR, 2) fwd_kernel(Args a) {
    extern __shared__ __attribute__((aligned(16))) unsigned char lds_raw[];
    LAS unsigned char* lds = (LAS unsigned char*)lds_raw;
    const int tid0 = threadIdx.x;
    const int G = gridDim.x, bid0 = blockIdx.x;
    unsigned char* ws0 = a.ws;

#pragma unroll 1
    for (int ph = a.ph_lo; ph < a.ph_hi; ++ph) {
        int tid = tid0, bid = bid0; unsigned char* ws = ws0;
        asm volatile("" : "+v"(tid)); asm volatile("" : "+s"(bid)); asm volatile("" : "+s"(ws));
        const int lane = tid & 63, wave = __builtin_amdgcn_readfirstlane(tid >> 6);
        const int gw = bid * NWAVES + wave, NGW = G * NWAVES;
        float* mod = (float*)(ws + WS_MOD);
        float* X1 = (float*)(ws + WS_X1);
        float* X2 = a.out;
        bf16* XN = (bf16*)(ws + WS_XN); bf16* HB = (bf16*)(ws + WS_HB);
        bf16* Zb = (bf16*)a.out; bf16* GBb = (bf16*)a.out + (size_t)M * D;
        bf16* Ub = (bf16*)(ws + WS_U); bf16* SAb = (bf16*)(ws + WS_SA); bf16* SBb = (bf16*)(ws + WS_SB);
        bf16* Sb = (bf16*)(ws + WS_S); bf16* S2b = (bf16*)(ws + WS_S2);
        bool is_gemm = false, sync_after = true;
        pg8::Gemm g{nullptr, nullptr, M, 0, 0};
        Epi E{};
        switch (ph) {
        case 0: prologue(a, lds, tid, lane, wave, bid, G); break;
        case 1: norm_phase(a.in[0], a.in[4], mod + 0 * D, mod + 1 * D, XN, nullptr, gw, NGW, lane); break;
        case 2: is_gemm = true; g.A = XN; g.Bt = (const bf16*)(ws + WS_WUPA); g.N = NUP; g.K = D; E.mode = EM_SWIGLU; E.O = HB; E.ldc = FF; break;
        case 3: is_gemm = true; g.A = HB; g.Bt = (const bf16*)(ws + WS_WDNA); g.N = D; g.K = FF; E.mode = EM_RES; E.base = a.in[0]; E.outf = X1; E.gate = mod + 2 * D; E.coef = 0.5f; break;
        case 4: norm_phase(X1, a.in[8], mod + 3 * D, mod + 4 * D, XN, nullptr, gw, NGW, lane); break;
        case 5: is_gemm = true; g.A = XN; g.Bt = (const bf16*)(ws + WS_WIN); g.N = NIN; g.K = D; E.mode = EM_WIN; E.O = GBb; E.O2 = Zb; E.O3 = Ub; E.O4 = SAb; E.O5 = SBb; break;
        case 6: {
            if (wave < 4) {
                for (int job = bid * 4 + wave; job < BATCH * 32; job += G * 4)
                    ssm_job(job, lds + wave * 32768, Ub, Sb, (const float*)(ws + WS_ABAR), (const bf16*)(ws + WS_BMAT), (const bf16*)(ws + WS_CMAT), a.in[19], lane);
            } else {
                for (int j = bid * 4 + (wave - 4); j < BATCH * 128; j += G * 4) conv_job(j, Zb, GBb, a.in[10], lane);
            }
        } break;
        case 7: is_gemm = true; sync_after = false; g.A = GBb; g.Bt = (const bf16*)(ws + WS_WC); g.N = D; g.K = D; E.mode = EM_MULA; E.O = SAb; E.P = SAb; E.ldc = D; break;
        case 8: is_gemm = true; g.A = Sb; g.Bt = (const bf16*)(ws + WS_WG); g.N = SW; g.K = SW; E.mode = EM_GLU; E.O = S2b; E.P = Sb; E.ldc = SW; break;
        case 9: is_gemm = true; g.A = S2b; g.Bt = (const bf16*)(ws + WS_WS); g.N = D; g.K = SW; E.mode = EM_MERGE; E.O = SAb; E.P = SAb; E.Q = SBb; E.ldc = D; break;
        case 10: is_gemm = true; g.A = SAb; g.Bt = (const bf16*)(ws + WS_WO); g.N = D; g.K = D; E.mode = EM_RES; E.base = X1; E.outf = X2; E.gate = mod + 5 * D; E.coef = 1.0f; break;
        case 11: norm_phase(X2, a.in[23], mod + 6 * D, mod + 7 * D, XN, nullptr, gw, NGW, lane); break;
        case 12: is_gemm = true; g.A = XN; g.Bt = (const bf16*)(ws + WS_WUPB); g.N = NUP; g.K = D; E.mode = EM_SWIGLU; E.O = HB; E.ldc = FF; break;
        case 13: is_gemm = true; g.A = HB; g.Bt = (const bf16*)(ws + WS_WDNB); g.N = D; g.K = FF; E.mode = EM_RES; E.base = X2; E.outf = X1; E.gate = mod + 8 * D; E.coef = 0.5f; break;
        case 14: norm_phase(X1, a.in[27], nullptr, nullptr, nullptr, a.out, gw, NGW, lane); break;
        default: break;
        }
        if (is_gemm) {
            pg8::StaticOrder S; S.init(g.M, g.N, G, bid);
            pg8::gemm_phase<Epi, pg8::StaticOrder, true, true>(lds, g, S, E);
        }
        if (ph + 1 < a.ph_hi && sync_after) cg::this_grid().sync();
    }
}

#ifndef MK_MULTI
#define MK_MULTI 0
#endif
extern "C" void kernel_launch(void* const* d_in, const int* in_sizes, int n_in, void* d_out, int out_size, void* d_ws, size_t ws_size, hipStream_t stream) {
    static int grid = 0;
    if (grid == 0) {
        if (n_in != 28 || in_sizes[0] != M * D || out_size != M * D || ws_size < WS_END) { fprintf(stderr, "kernel_launch: unexpected shapes (n_in %d, in0 %d, out %d, ws %zu)\n", n_in, n_in > 0 ? in_sizes[0] : -1, out_size, ws_size); grid = -1; return; }
        int dev = 0, cus = 0, per_cu = 0;
        if (hipGetDevice(&dev) != hipSuccess || hipDeviceGetAttribute(&cus, hipDeviceAttributeMultiprocessorCount, dev) != hipSuccess) { grid = -1; return; }
        if (hipFuncSetAttribute((const void*)fwd_kernel, hipFuncAttributeMaxDynamicSharedMemorySize, LDS_BYTES) != hipSuccess) { fprintf(stderr, "kernel_launch: hipFuncSetAttribute failed\n"); grid = -1; return; }
        if (hipOccupancyMaxActiveBlocksPerMultiprocessor(&per_cu, (const void*)fwd_kernel, NTHR, LDS_BYTES) != hipSuccess || per_cu < 1) { fprintf(stderr, "kernel_launch: occupancy query says %d\n", per_cu); per_cu = 1; }
        (void)hipGetLastError();
        grid = cus * per_cu;
        fprintf(stderr, "kernel_launch: grid %d (cus %d x %d)\n", grid, cus, per_cu);
    }
    if (grid < 0) return;
    Args a{};
    for (int i = 0; i < 28; ++i) a.in[i] = (const float*)d_in[i];
    a.out = (float*)d_out; a.ws = (unsigned char*)d_ws;
#if MK_MULTI
    for (int ph = 0; ph < NPH; ++ph) { a.ph_lo = ph; a.ph_hi = ph + 1; hipLaunchKernelGGL(fwd_kernel, dim3(grid), dim3(NTHR), LDS_BYTES, stream, a); }
#else
    a.ph_lo = 0; a.ph_hi = NPH;
    void* kargs[] = {(void*)&a};
    hipError_t e = hipLaunchCooperativeKernel((const void*)fwd_kernel, dim3(grid), dim3(NTHR), kargs, LDS_BYTES, stream);
    if (e != hipSuccess) fprintf(stderr, "kernel_launch: cooperative launch failed: %s (grid %d)\n", hipGetErrorString(e), grid);
#endif
}
```

```cpp
#include <hip/hip_runtime.h>
#include <hip/hip_cooperative_groups.h>
#include <cstdio>
#include <cstdint>
namespace cg = cooperative_groups;
namespace pg8 {
#define PG8_LAS __attribute__((address_space(3)))
typedef unsigned short bf16_t;
typedef short bf16x8 __attribute__((ext_vector_type(8)));
typedef float f32x4 __attribute__((ext_vector_type(4)));
typedef unsigned u32x4 __attribute__((ext_vector_type(4)));
constexpr int BM = 256, BK = 64, HALF = 128, HTB = HALF * BK * 2  , STAGE_BYTES = 8 * HTB, NXCD = 8, WGM = 8;

__host__ __device__ __forceinline__ int lds_byte(int r, int c) { const int st = (r >> 4) * 2 + (c >> 5), rr = r & 15, cc = c & 31, ob = rr * 64 + cc * 2; return st * 1024 + (ob ^ (((ob >> 9) & 1) << 5)); }
__host__ __device__ __forceinline__ void stage_rc(int b, int& R, int& C) { const int st = b / 1024, sb = b % 1024, swz = sb ^ (((sb >> 9) & 1) << 5); R = (st >> 1) * 16 + swz / 64; C = (st & 1) * 32 + (swz % 64) / 2; }
__host__ __device__ __forceinline__ int perm32(int rho) { const int n = rho >> 4, i = rho & 15; return 8 * (i >> 2) + 4 * n + (i & 3); }

struct Unit { int pm, pn; };
struct Gemm { const bf16_t* A; const bf16_t* Bt; int M, N, K; };

struct StaticOrder {
    int nM, nN, nwg, G, c;
    __host__ __device__ void init(int M, int N, int G_, int c_) { nM = M / BM; nN = N / BM; nwg = nM * nN; G = G_; c = c_; }
    __host__ __device__ bool next(int i, Unit& u) const {
        const long L = (long)i * G + c; if (L >= nwg) return false;
        int wgid = (int)L; { const int q = nwg / NXCD, r = nwg % NXCD, xcd = wgid % NXCD, off = wgid / NXCD; wgid = (xcd < r ? xcd * (q + 1) : r * (q + 1) + (xcd - r) * q) + off; }
        const int nig = WGM * nN, gid = wgid / nig, fm = gid * WGM, gsz = (nM - fm) < WGM ? (nM - fm) : WGM;
        u.pm = fm + ((wgid % nig) % gsz); u.pn = (wgid % nig) / gsz; return true;
    }
    __device__ __forceinline__ void a_ready(const Unit&) const {}
    __device__ __forceinline__ void done(const Unit&) const {}
};

__device__ __forceinline__ unsigned cvt_pk_bf16(float lo, float hi) { unsigned r; asm volatile("v_cvt_pk_bf16_f32 %0, %1, %2" : "=v"(r) : "v"(lo), "v"(hi)); return r; }
template <class Epi, class Sched, bool ALIGN_EPI = false, bool SP2 = false>
__device__ __forceinline__ void gemm_phase(PG8_LAS unsigned char* lds, const Gemm g, const Sched& S, const Epi& E) {
    const int tid = threadIdx.x, wid = __builtin_amdgcn_readfirstlane(tid >> 6), lane = tid & 63, wr = wid >> 2, wc = wid & 3, fr = lane & 15, fq = lane >> 4;
    const int K = g.K, nt = K / BK;
    unsigned voffA[2], voffB[2];
#pragma unroll
    for (int i = 0; i < 2; ++i) { int R, C; stage_rc(tid * 16 + i * 8192, R, C); const int Rb = Epi::PERM ? ((R & ~31) + perm32(R & 31)) : R;
        voffA[i] = (unsigned)(R * K + C) * 2u; voffB[i] = (unsigned)(Rb * K + C) * 2u; }
    const size_t kstep = (size_t)(BK * 2);
    const size_t hstep = (size_t)HALF * K * 2;
    const size_t tstep = 2 * hstep;
    const unsigned ldsw = (unsigned)wid * 1024u;
    const int aoff = lds_byte(wr * 64 + fr, fq * 8), boff = lds_byte(wc * 32 + fr, fq * 8);
#define PG8_SA(b, h) (((b) * 2 + (h)) * HTB)
#define PG8_SB(b, h) ((4 + (b) * 2 + (h)) * HTB)
#define PG8_STAGE(bufoff, gbase, voff) do { _Pragma("unroll") for (int _i = 0; _i < 2; ++_i) \
        __builtin_amdgcn_global_load_lds((const unsigned*)((const char*)(gbase) + (voff)[_i]), (PG8_LAS unsigned*)(lds + (bufoff) + ldsw + _i * 8192), 16, 0, 0); } while (0)
#define PG8_LDA(dst, b, h) do { _Pragma("unroll") for (int m = 0; m < 4; ++m) _Pragma("unroll") for (int k = 0; k < 2; ++k) dst[m][k] = *(const PG8_LAS bf16x8*)(lds + PG8_SA(b, h) + aoff + m * 2048 + k * 1024); } while (0)
#define PG8_LDB(dst, b, h) do { _Pragma("unroll") for (int n = 0; n < 2; ++n) _Pragma("unroll") for (int k = 0; k < 2; ++k) dst[n][k] = *(const PG8_LAS bf16x8*)(lds + PG8_SB(b, h) + boff + n * 2048 + k * 1024); } while (0)
#define PG8_MMA(ai, bj, At, Bt) do { __builtin_amdgcn_s_setprio(1); _Pragma("unroll") for (int m = 0; m < 4; ++m) _Pragma("unroll") for (int n = 0; n < 2; ++n) _Pragma("unroll") for (int k = 0; k < 2; ++k) \
        acc[ai][bj][m][n] = __builtin_amdgcn_mfma_f32_16x16x32_bf16(Bt[n][k], At[m][k], acc[ai][bj][m][n], 0, 0, 0); __builtin_amdgcn_s_setprio(0); } while (0)
#define PG8_WAIT_V(n) asm volatile("s_waitcnt vmcnt(" #n ")" ::: "memory")
#define PG8_WAIT_L(n) asm volatile("s_waitcnt lgkmcnt(" #n ")" ::: "memory")
#define PG8_BAR __builtin_amdgcn_s_barrier()
#define PG8_SCHED __builtin_amdgcn_sched_barrier(0)
    Unit cur, nxt; int ui = 0;
    if (!S.next(0, cur)) return;
    f32x4 acc[2][2][4][2];
#pragma unroll
    for (int a = 0; a < 2; ++a)
#pragma unroll
        for (int b = 0; b < 2; ++b)
#pragma unroll
            for (int m = 0; m < 4; ++m)
#pragma unroll
                for (int n = 0; n < 2; ++n) acc[a][b][m][n] = (f32x4){0.f, 0.f, 0.f, 0.f};
    bf16x8 At[4][2], B0[2][2], B1[2][2];
    const char* cA = (const char*)g.A + (size_t)cur.pm * tstep; const char* cB = (const char*)g.Bt + (size_t)cur.pn * tstep;
    S.a_ready(cur);
    if constexpr (SP2) {
        PG8_STAGE(PG8_SB(0, 0), cB, voffB); PG8_STAGE(PG8_SB(0, 1), cB + hstep, voffB); PG8_STAGE(PG8_SA(0, 0), cA, voffA); PG8_STAGE(PG8_SA(0, 1), cA + hstep, voffA);
        if (wr == 1) PG8_BAR;
        PG8_WAIT_V(2); PG8_BAR;
        PG8_STAGE(PG8_SB(1, 0), cB + kstep, voffB); PG8_STAGE(PG8_SA(1, 0), cA + kstep, voffA); PG8_STAGE(PG8_SB(1, 1), cB + hstep + kstep, voffB);
        PG8_WAIT_V(6); PG8_BAR;
    } else {
        PG8_STAGE(PG8_SB(0, 0), cB, voffB); PG8_STAGE(PG8_SA(0, 0), cA, voffA); PG8_STAGE(PG8_SB(0, 1), cB + hstep, voffB); PG8_STAGE(PG8_SA(0, 1), cA + hstep, voffA);
        if (wr == 1) PG8_BAR;
        PG8_WAIT_V(4); PG8_BAR;
        PG8_STAGE(PG8_SB(1, 0), cB + kstep, voffB); PG8_STAGE(PG8_SA(1, 0), cA + kstep, voffA); PG8_STAGE(PG8_SB(1, 1), cB + hstep + kstep, voffB);
        PG8_WAIT_V(6); PG8_BAR;
    }
    for (;;) {
        const bool has_next = S.next(ui + 1, nxt);
        const char* nA = has_next ? (const char*)g.A + (size_t)nxt.pm * tstep : cA; const char* nB = has_next ? (const char*)g.Bt + (size_t)nxt.pn * tstep : cB;
        for (int t = 0; t < nt; t += 2) {
            const bool last = (t == nt - 2);
            const char* a1 = cA + (size_t)(t + 1) * kstep;
            const char* a2 = last ? nA : cA + (size_t)(t + 2) * kstep; const char* b2 = last ? nB : cB + (size_t)(t + 2) * kstep;
            const char* a3 = a2 + kstep; const char* b3 = b2 + kstep;
            if (last && has_next) S.a_ready(nxt);
            if constexpr (SP2) {
            PG8_LDB(B0, 0, 0); PG8_LDB(B1, 0, 1); PG8_SCHED; PG8_LDA(At, 0, 0); PG8_STAGE(PG8_SA(1, 1), a1 + hstep, voffA);
            PG8_WAIT_V(8); PG8_WAIT_L(0); PG8_BAR; PG8_MMA(0, 0, At, B0); PG8_MMA(0, 1, At, B1); PG8_BAR; PG8_SCHED;
            PG8_LDA(At, 0, 1); PG8_STAGE(PG8_SB(0, 0), b2, voffB); PG8_STAGE(PG8_SB(0, 1), b2 + hstep, voffB); PG8_STAGE(PG8_SA(0, 0), a2, voffA);
            PG8_WAIT_V(8); PG8_WAIT_L(0); PG8_BAR; PG8_MMA(1, 0, At, B0); PG8_MMA(1, 1, At, B1); PG8_BAR; PG8_SCHED;
            PG8_LDB(B0, 1, 0); PG8_LDB(B1, 1, 1); PG8_SCHED; PG8_LDA(At, 1, 0); PG8_STAGE(PG8_SA(0, 1), a2 + hstep, voffA);
            PG8_WAIT_V(8); PG8_WAIT_L(0); PG8_BAR; PG8_MMA(0, 0, At, B0); PG8_MMA(0, 1, At, B1); PG8_BAR; PG8_SCHED;
            PG8_LDA(At, 1, 1); PG8_STAGE(PG8_SB(1, 0), b3, voffB); PG8_STAGE(PG8_SB(1, 1), b3 + hstep, voffB); PG8_STAGE(PG8_SA(1, 0), a3, voffA);
            PG8_WAIT_V(8); PG8_WAIT_L(0); PG8_BAR; PG8_MMA(1, 0, At, B0); PG8_MMA(1, 1, At, B1); PG8_BAR; PG8_SCHED;
            } else {
            PG8_LDB(B0, 0, 0); PG8_SCHED; PG8_LDA(At, 0, 0); PG8_STAGE(PG8_SA(1, 1), a1 + hstep, voffA);
            PG8_WAIT_L(8); PG8_BAR; PG8_WAIT_L(0); PG8_MMA(0, 0, At, B0); PG8_BAR; PG8_SCHED;
            PG8_LDB(B1, 0, 1); PG8_STAGE(PG8_SB(0, 0), b2, voffB);
            PG8_BAR; PG8_WAIT_L(0); PG8_MMA(0, 1, At, B1); PG8_BAR;
            PG8_LDA(At, 0, 1); PG8_STAGE(PG8_SA(0, 0), a2, voffA);
            PG8_BAR; PG8_WAIT_L(0); PG8_MMA(1, 0, At, B0); PG8_BAR; PG8_SCHED;
            PG8_STAGE(PG8_SB(0, 1), b2 + hstep, voffB);
            PG8_WAIT_V(6); PG8_BAR; PG8_MMA(1, 1, At, B1); PG8_BAR;
            PG8_LDB(B0, 1, 0); PG8_SCHED; PG8_LDA(At, 1, 0); PG8_STAGE(PG8_SA(0, 1), a2 + hstep, voffA);
            PG8_WAIT_L(8); PG8_BAR; PG8_WAIT_L(0); PG8_MMA(0, 0, At, B0); PG8_BAR; PG8_SCHED;
            PG8_LDB(B1, 1, 1); PG8_STAGE(PG8_SB(1, 0), b3, voffB);
            PG8_BAR; PG8_WAIT_L(0); PG8_MMA(0, 1, At, B1); PG8_BAR;
            PG8_LDA(At, 1, 1); PG8_STAGE(PG8_SA(1, 0), a3, voffA);
            PG8_BAR; PG8_WAIT_L(0); PG8_MMA(1, 0, At, B0); PG8_BAR; PG8_SCHED;
            PG8_STAGE(PG8_SB(1, 1), b3 + hstep, voffB);
            PG8_WAIT_V(6); PG8_BAR; PG8_MMA(1, 1, At, B1); PG8_BAR;
            }
        }
        if constexpr (ALIGN_EPI) { if (wr == 0) PG8_BAR; }
        if constexpr (!Epi::AFTER_DRAIN) { E(acc, cur, wr, wc, fr, fq); S.done(cur); }
        if (!has_next) break;
#pragma unroll
        for (int a = 0; a < 2; ++a)
#pragma unroll
            for (int b = 0; b < 2; ++b)
#pragma unroll
                for (int m = 0; m < 4; ++m)
#pragma unroll
                    for (int n = 0; n < 2; ++n) acc[a][b][m][n] = (f32x4){0.f, 0.f, 0.f, 0.f};
        cur = nxt; cA = nA; cB = nB; ++ui;
        if constexpr (ALIGN_EPI) { if (wr == 1) PG8_BAR; }
    }
    PG8_WAIT_V(0);
    if constexpr (!ALIGN_EPI) { if (wr == 0) PG8_BAR; }
    PG8_BAR;
    if constexpr (Epi::AFTER_DRAIN) { E.fused(acc, cur, wr, wc, fr, fq, lds, wid, lane); S.done(cur); }
#undef PG8_SA
#undef PG8_SB
#undef PG8_STAGE
#undef PG8_LDA
#undef PG8_LDB
#undef PG8_MMA
#undef PG8_WAIT_V
#undef PG8_WAIT_L
#undef PG8_BAR
#undef PG8_SCHED
}
}

constexpr int BATCH = 32, SEQ = 2048, D = 1024, M = BATCH * SEQ, FF = 2816, NUP = 2 * FF, NIN = 5632;
constexpr int SW = 512, NMODC = 9 * D;
constexpr float EPS = 1e-6f;
constexpr int NWAVES = 8, NTHR = 512;
constexpr int LDS_BYTES = 147456;
constexpr size_t MiB = 1u << 20;
constexpr size_t WS_BAR = 0, WS_BAR_BYTES = 16384;
constexpr size_t WS_MOD = 1 * MiB, WS_ABAR = 3 * MiB, WS_BMAT = 3 * MiB + 64 * 1024, WS_CMAT = 3 * MiB + 256 * 1024;
constexpr size_t WS_WUPA = 4 * MiB, WS_WDNA = 15 * MiB, WS_WIN = 21 * MiB, WS_WC = 32 * MiB, WS_WG = 34 * MiB, WS_WS = 35 * MiB, WS_WO = 36 * MiB, WS_WUPB = 38 * MiB, WS_WDNB = 49 * MiB;
constexpr size_t WS_X1 = 56 * MiB, WS_XN = 312 * MiB, WS_S = 312 * MiB, WS_S2 = 376 * MiB, WS_HB = 440 * MiB, WS_U = 440 * MiB, WS_SA = 504 * MiB, WS_SB = 632 * MiB, WS_YA = 792 * MiB, WS_END = 920 * MiB;

#define LAS __attribute__((address_space(3)))
typedef unsigned short bf16;
typedef unsigned u32x4 __attribute__((ext_vector_type(4)));
typedef unsigned u32x2 __attribute__((ext_vector_type(2)));
typedef float f32x4 __attribute__((ext_vector_type(4)));
typedef float f32x2 __attribute__((ext_vector_type(2)));
typedef float f32x16 __attribute__((ext_vector_type(16)));
typedef short bf16x8 __attribute__((ext_vector_type(8)));
#define LDS_WAIT() asm volatile("s_waitcnt lgkmcnt(0)" ::: "memory")

__device__ __forceinline__ unsigned pk2(float lo, float hi) { return pg8::cvt_pk_bf16(lo, hi); }
__device__ __forceinline__ float bflo(unsigned w) { return __uint_as_float(w << 16); }
__device__ __forceinline__ float bfhi(unsigned w) { return __uint_as_float(w & 0xffff0000u); }
__device__ __forceinline__ float bf2f(bf16 v) { return __uint_as_float((unsigned)v << 16); }
__device__ __forceinline__ float fsigmoid(float x) { return __builtin_amdgcn_rcpf(1.0f + __builtin_amdgcn_exp2f(-1.44269504f * x)); }
__device__ __forceinline__ float fsilu(float x) { return x * fsigmoid(x); }
__device__ __forceinline__ float fgelu_tanh(float x) { const float u = x + 0.044715f * x * x * x; return x * __builtin_amdgcn_rcpf(1.0f + __builtin_amdgcn_exp2f(-2.0f * 0.7978845608f * 1.44269504f * u)); }
__device__ __forceinline__ void unpack8(const u32x4 w, float (&f)[8]) { f[0] = bflo(w.x); f[1] = bfhi(w.x); f[2] = bflo(w.y); f[3] = bfhi(w.y); f[4] = bflo(w.z); f[5] = bfhi(w.z); f[6] = bflo(w.w); f[7] = bfhi(w.w); }
__device__ __forceinline__ u32x4 pack8(const float (&f)[8]) { u32x4 w; w.x = pk2(f[0], f[1]); w.y = pk2(f[2], f[3]); w.z = pk2(f[4], f[5]); w.w = pk2(f[6], f[7]); return w; }
__device__ __forceinline__ float wave_sum(float v) {
#pragma unroll
    for (int o = 1; o < 64; o <<= 1) v += __shfl_xor(v, o);
    return v;
}

#define XB_TMO      128
#define XB_XCNT(j)  (256  + 64 * (j))
#define XB_XSUB(j)  (1280 + 64 * (j))
#define XB_XGEN(j)  (2304 + 64 * (j))
#define XB_TOP      3328
#define XB_TOPGEN   3392
#define XCD_BAR_WORDS 3456
#define XB_SPIN_CAP (1u << 18)

__device__ __forceinline__ unsigned xb_ld(unsigned* p)              { return __hip_atomic_load(p, __ATOMIC_RELAXED, __HIP_MEMORY_SCOPE_AGENT); }
__device__ __forceinline__ unsigned xb_add(unsigned* p, unsigned v) { return __hip_atomic_fetch_add(p, v, __ATOMIC_RELAXED, __HIP_MEMORY_SCOPE_AGENT); }
__device__ __forceinline__ unsigned xb_xcc_id() { return (unsigned)__builtin_amdgcn_s_getreg((3 << 11) | 20) & 0xFu; }
#define XB_SPIN(cond, bar) do { unsigned _sp = 0; while (cond) { __builtin_amdgcn_s_sleep(1); \
    if ((++_sp & 255u) == 0u) { if (xb_ld(&(bar)[XB_TMO])) break; if (_sp > XB_SPIN_CAP) { atomicAdd(&(bar)[XB_TMO], 1u); break; } } } } while (0)

struct XcdBarrier {
    unsigned* bar; unsigned x;
    volatile LAS unsigned* st;
};

__device__ __forceinline__ XcdBarrier xcd_barrier_post(unsigned* bar, volatile LAS unsigned* st) {
    XcdBarrier b; b.bar = bar; b.x = xb_xcc_id(); b.st = st;
    if (threadIdx.x == 0) (void)xb_add(&bar[XB_XCNT(b.x)], 1u);
    return b;
}
__device__ __forceinline__ void xcd_barrier_complete(unsigned* bar, unsigned x, unsigned& nloc, unsigned& nx) {
    const unsigned G = gridDim.x * gridDim.y * gridDim.z;
    unsigned sum, cnt, mine, sp = 0u;
    for (;;) {
        sum = 0u; cnt = 0u; mine = 0u;
#pragma unroll
        for (unsigned j = 0; j < 16; ++j) { const unsigned c = xb_ld(&bar[XB_XCNT(j)]); sum += c; cnt += (c > 0u) ? 1u : 0u; mine = (j == x) ? c : mine; }
        if (sum == G) break;
        __builtin_amdgcn_s_sleep(1);
        if ((++sp & 255u) == 0u) { if (xb_ld(&bar[XB_TMO])) break; if (sp > XB_SPIN_CAP) { atomicAdd(&bar[XB_TMO], 1u); break; } }
    }
    nloc = mine > 0u ? mine : 1u; nx = cnt > 0u ? cnt : 1u;
}

__device__ __forceinline__ void xcd_barrier(const XcdBarrier& b) {
    asm volatile("s_waitcnt vmcnt(0)" ::: "memory");
    __syncthreads();
    if (threadIdx.x == 0) {
        unsigned* bar = b.bar;
        __builtin_amdgcn_s_waitcnt(0);
        unsigned nloc = b.st[0], nx = b.st[1];
        if (nloc == 0u) { xcd_barrier_complete(bar, b.x, nloc, nx); b.st[0] = nloc; b.st[1] = nx; }
        const unsigned old = xb_add(&bar[XB_XSUB(b.x)], 1u);
        const unsigned gen = old / nloc;
        if (old + 1u == (gen + 1u) * nloc) {
            __builtin_amdgcn_fence(__ATOMIC_RELEASE, "agent");
            asm volatile("s_waitcnt vmcnt(0)" ::: "memory");
            const unsigned og = xb_add(&bar[XB_TOP], 1u);
            const unsigned tg = og / nx;
            if (og + 1u == (tg + 1u) * nx) xb_add(&bar[XB_TOPGEN], 1u);
            else XB_SPIN(xb_ld(&bar[XB_TOPGEN]) == tg, bar);
            __builtin_amdgcn_fence(__ATOMIC_ACQUIRE, "agent");
            xb_add(&bar[XB_XGEN(b.x)], 1u);
            asm volatile("s_waitcnt vmcnt(0)" ::: "memory");
        } else {
            XB_SPIN(xb_ld(&bar[XB_XGEN(b.x)]) == gen, bar);
            __builtin_amdgcn_fence(__ATOMIC_ACQUIRE, "agent");
            asm volatile("s_waitcnt vmcnt(0)" ::: "memory");
        }
    }
    __syncthreads();
}

enum { EM_SWIGLU = 0, EM_RES = 1, EM_WIN = 2, EM_MULA = 3, EM_GLU = 4, EM_MERGE = 5 };
struct Epi {
    static constexpr bool PERM = true, AFTER_DRAIN = false;
    int mode;
    bf16* O; int ldc;
    bf16 *O2, *O3, *O4, *O5;
    const bf16* P; const bf16* Q;
    const float* base; float* outf; const float* gate; float coef;
    __device__ __forceinline__ void operator()(const f32x4 (&acc)[2][2][4][2], const pg8::Unit& u, int wr, int wc, int fr, int fq) const {
        const int row0 = u.pm * 256 + wr * 64 + fr;
        const int cw = wc * 32 + 8 * fq;
        if (mode == EM_SWIGLU) {
            bf16* bp = O + (size_t)row0 * ldc + u.pn * 128 + cw;
#pragma unroll
            for (int ai = 0; ai < 2; ++ai)
#pragma unroll
                for (int m = 0; m < 4; ++m) {
                    float o[8];
#pragma unroll
                    for (int n = 0; n < 2; ++n)
#pragma unroll
                        for (int j = 0; j < 4; ++j) o[4 * n + j] = fsilu(acc[ai][0][m][n][j]) * acc[ai][1][m][n][j];
                    *(u32x4*)(bp + (size_t)(ai * 128 + m * 16) * ldc) = pack8(o);
                }
        } else if (mode == EM_RES) {
            const int b = u.pm >> 3;
            const float* gp = gate + (size_t)b * NMODC + u.pn * 256 + cw;
            f32x4 gv[2][2];
#pragma unroll
            for (int bj = 0; bj < 2; ++bj)
#pragma unroll
                for (int n = 0; n < 2; ++n) gv[bj][n] = *(const f32x4*)(gp + bj * 128 + 4 * n) * coef;
#pragma unroll
            for (int ai = 0; ai < 2; ++ai)
#pragma unroll
                for (int m = 0; m < 4; ++m) {
                    const size_t off = (size_t)(row0 + ai * 128 + m * 16) * D + u.pn * 256 + cw;
#pragma unroll
                    for (int bj = 0; bj < 2; ++bj)
#pragma unroll
                        for (int n = 0; n < 2; ++n) {
                            const f32x4 bs = *(const f32x4*)(base + off + bj * 128 + 4 * n);
                            *(f32x4*)(outf + off + bj * 128 + 4 * n) = bs + gv[bj][n] * acc[ai][bj][m][n];
                        }
                    if (m & 1) asm volatile("" ::: "memory");
                }
        } else if (mode == EM_WIN) {
            const int pn = u.pn;
            if (pn >= 4 && pn < 12) {
                bf16* bp = O2 + (size_t)row0 * D + (pn - 4) * 128 + cw;
#pragma unroll
                for (int ai = 0; ai < 2; ++ai)
#pragma unroll
                    for (int m = 0; m < 4; ++m) {
                        float o[8];
#pragma unroll
                        for (int n = 0; n < 2; ++n)
#pragma unroll
                            for (int j = 0; j < 4; ++j) o[4 * n + j] = acc[ai][0][m][n][j] * acc[ai][1][m][n][j];
                        *(u32x4*)(bp + (size_t)(ai * 128 + m * 16) * D) = pack8(o);
                    }
            } else {
                bf16* dst; int ld, colt; bool sig;
                if (pn < 4) { dst = O; ld = D; colt = pn * 256; sig = false; }
                else if (pn < 14) { dst = O3; ld = SW; colt = (pn - 12) * 256; sig = false; }
                else if (pn < 18) { dst = O4; ld = D; colt = (pn - 14) * 256; sig = true; }
                else { dst = O5; ld = D; colt = (pn - 18) * 256; sig = true; }
                bf16* bp = dst + (size_t)row0 * ld + colt + cw;
#pragma unroll
                for (int ai = 0; ai < 2; ++ai)
#pragma unroll
                    for (int m = 0; m < 4; ++m)
#pragma unroll
                        for (int bj = 0; bj < 2; ++bj) {
                            float o[8];
#pragma unroll
                            for (int n = 0; n < 2; ++n)
#pragma unroll
                                for (int j = 0; j < 4; ++j) { const float v = acc[ai][bj][m][n][j]; o[4 * n + j] = sig ? fsigmoid(v) : v; }
                            *(u32x4*)(bp + (size_t)(ai * 128 + m * 16) * ld + bj * 128) = pack8(o);
                        }
            }
        } else {
            const size_t off0 = (size_t)row0 * ldc + u.pn * 256 + cw;
#pragma unroll
            for (int ai = 0; ai < 2; ++ai)
#pragma unroll
                for (int m = 0; m < 4; ++m) {
#pragma unroll
                    for (int bj = 0; bj < 2; ++bj) {
                        const size_t off = off0 + (size_t)(ai * 128 + m * 16) * ldc + bj * 128;
                        float p[8], q[8], o[8];
                        unpack8(*(const u32x4*)(P + off), p);
                        if (mode == EM_MERGE) unpack8(*(const u32x4*)(Q + off), q);
#pragma unroll
                        for (int n = 0; n < 2; ++n)
#pragma unroll
                            for (int j = 0; j < 4; ++j) {
                                const float v = acc[ai][bj][m][n][j];
                                o[4 * n + j] = (mode == EM_MULA) ? p[4 * n + j] * v : (mode == EM_GLU) ? p[4 * n + j] * fsigmoid(v) : p[4 * n + j] + q[4 * n + j] * v;
                            }
                        *(u32x4*)(O + off) = pack8(o);
                    }
                    if (m & 1) asm volatile("" ::: "memory");
                }
        }
    }
};

__device__ __forceinline__ void tr_item(const float* W, int K, int N, int k0, int n0, bf16* WT, int drow0, LAS float* scr, int lane) {
#pragma unroll 8
    for (int i = 0; i < 32; ++i) { const int kk = 2 * i + (lane >> 5); scr[kk * 33 + (lane & 31)] = W[(size_t)(k0 + kk) * N + n0 + (lane & 31)]; }
    LDS_WAIT();
    const int c = lane & 7;
#pragma unroll
    for (int j = 0; j < 4; ++j) {
        const int n = (lane >> 3) + 8 * j; const LAS float* s = scr + (8 * c) * 33 + n;
        u32x4 o; o.x = pk2(s[0 * 33], s[1 * 33]); o.y = pk2(s[2 * 33], s[3 * 33]); o.z = pk2(s[4 * 33], s[5 * 33]); o.w = pk2(s[6 * 33], s[7 * 33]);
        *(u32x4*)(WT + (size_t)(drow0 + n) * K + k0 + 8 * c) = o;
    }
    LDS_WAIT();
}
enum { MAP_PLAIN = 0, MAP_UP1 = 1, MAP_UP3 = 2, MAP_WIN = 3 };
__device__ __forceinline__ int map_row(int map, int n0) {
    if (map == MAP_PLAIN) return n0;
    if (map == MAP_UP1) return 256 * (n0 >> 7) + (n0 & 127);
    if (map == MAP_UP3) return 256 * (n0 >> 7) + 128 + (n0 & 127);
    if (n0 < 1024 || n0 >= 3072) return n0;
    if (n0 < 2048) { const int cc = n0 - 1024; return 1024 + 256 * (cc >> 7) + (cc & 127); }
    { const int cc = n0 - 2048; return 1024 + 256 * (cc >> 7) + 128 + (cc & 127); }
}

struct Args { const float* in[28]; float* out; unsigned char* ws; int ph_lo, ph_hi; };

__device__ __forceinline__ void prologue(const Args& a, LAS unsigned char* lds, int tid, int lane, int wave, int bid, int G) {
    unsigned char* ws = a.ws;
    for (int job = bid; job < NMODC / 32; job += G) {
        const int n0 = job * 32, l31 = lane & 31, h5 = lane >> 5;
        f32x16 acc;
#pragma unroll
        for (int r = 0; r < 16; ++r) acc[r] = 0.f;
        const float* cp = a.in[1] + (size_t)l31 * D + wave * 128 + 8 * h5;
        const float* wp = a.in[2] + (size_t)(wave * 128 + 8 * h5) * NMODC + n0 + l31;
#pragma unroll
        for (int kk = 0; kk < 8; ++kk) {
            const f32x4 c0 = *(const f32x4*)(cp + 16 * kk), c1 = *(const f32x4*)(cp + 16 * kk + 4);
            float wv[8];
#pragma unroll
            for (int j = 0; j < 8; ++j) wv[j] = wp[(size_t)(16 * kk + j) * NMODC];
            u32x4 ua, ub;
            ua.x = pk2(c0.x / (1.0f + __expf(-c0.x)), c0.y / (1.0f + __expf(-c0.y))); ua.y = pk2(c0.z / (1.0f + __expf(-c0.z)), c0.w / (1.0f + __expf(-c0.w)));
            ua.z = pk2(c1.x / (1.0f + __expf(-c1.x)), c1.y / (1.0f + __expf(-c1.y))); ua.w = pk2(c1.z / (1.0f + __expf(-c1.z)), c1.w / (1.0f + __expf(-c1.w)));
            ub.x = pk2(wv[0], wv[1]); ub.y = pk2(wv[2], wv[3]); ub.z = pk2(wv[4], wv[5]); ub.w = pk2(wv[6], wv[7]);
            acc = __builtin_amdgcn_mfma_f32_32x32x16_bf16(__builtin_bit_cast(bf16x8, ua), __builtin_bit_cast(bf16x8, ub), acc, 0, 0, 0);
        }
        LAS float* part = (LAS float*)lds;
#pragma unroll
        for (int r = 0; r < 16; ++r) part[(wave * 32 + (r & 3) + 8 * (r >> 2) + 4 * h5) * 32 + l31] = acc[r];
        __syncthreads();
        float* mod = (float*)(ws + WS_MOD);
        for (int o = tid; o < 1024; o += NTHR) {
            const int b = o >> 5, n = o & 31; float sacc = a.in[3][n0 + n];
#pragma unroll
            for (int w8 = 0; w8 < 8; ++w8) sacc += part[(w8 * 32 + b) * 32 + n];
            mod[(size_t)b * NMODC + n0 + n] = sacc;
        }
        __syncthreads();
    }
    if (bid >= G - 4) {
        const int g = (bid - (G - 4)) * 8 + wave, p = lane;
        const float dt = expf(a.in[18][g]);
        const float ar = a.in[12][g * 64 + p], ai = a.in[13][g * 64 + p];
        const float e = expf(ar * dt); float sn, cs; sincosf(ai * dt, &sn, &cs);
        const float abr = e * cs, abi = e * sn;
        const float nr = abr - 1.0f, ni = abi, den = ar * ar + ai * ai;
        const float cr = (nr * ar + ni * ai) / den, ci = (ni * ar - nr * ai) / den;
        float* abar = (float*)(ws + WS_ABAR);
        abar[2 * (g * 64 + p)] = abr; abar[2 * (g * 64 + p) + 1] = abi;
        bf16* Bm = (bf16*)(ws + WS_BMAT);
        unsigned* Cm = (unsigned*)(ws + WS_CMAT);
        float re[16], im[16];
#pragma unroll
        for (int h = 0; h < 16; ++h) { const float br = a.in[14][(size_t)(g * 64 + p) * 16 + h], bi = a.in[15][(size_t)(g * 64 + p) * 16 + h]; re[h] = cr * br - ci * bi; im[h] = cr * bi + ci * br; }
        u32x4* d0 = (u32x4*)(Bm + (size_t)(g * 128 + 2 * p) * 16);
        { u32x4 w0, w1, w2, w3;
          w0.x = pk2(re[0], re[1]); w0.y = pk2(re[2], re[3]); w0.z = pk2(re[4], re[5]); w0.w = pk2(re[6], re[7]);
          w1.x = pk2(re[8], re[9]); w1.y = pk2(re[10], re[11]); w1.z = pk2(re[12], re[13]); w1.w = pk2(re[14], re[15]);
          w2.x = pk2(im[0], im[1]); w2.y = pk2(im[2], im[3]); w2.z = pk2(im[4], im[5]); w2.w = pk2(im[6], im[7]);
          w3.x = pk2(im[8], im[9]); w3.y = pk2(im[10], im[11]); w3.z = pk2(im[12], im[13]); w3.w = pk2(im[14], im[15]);
          d0[0] = w0; d0[1] = w1; d0[2] = w2; d0[3] = w3; }
#pragma unroll
        for (int h = 0; h < 16; ++h) Cm[(size_t)(g * 16 + h) * 64 + p] = pk2(a.in[16][(size_t)(g * 16 + h) * 64 + p], -a.in[17][(size_t)(g * 16 + h) * 64 + p]);
    }
    LAS float* scr = (LAS float*)(lds + wave * 16384);
    const int gw = bid * NWAVES + wave, NGW = G * NWAVES;
#define TRJ(idx, K_, N_, wsoff, MAP_) if (!found) { constexpr int items = ((K_) / 64) * ((N_) / 32); if (r < items) { found = true; W = a.in[idx]; K = (K_); N = (N_); WT = (bf16*)(ws + (wsoff)); map = (MAP_); } else r -= items; }
    constexpr int NITEMS = 2 * (3 * (D / 64) * (FF / 32)) + (D / 64) * (NIN / 32) + 2 * (D / 64) * (D / 32) + (SW / 64) * (SW / 32) + (SW / 64) * (D / 32);
#pragma unroll 1
    for (int it = gw; it < NITEMS; it += NGW) {
        int r = it; bool found = false; const float* W = nullptr; int K = 64, N = 32, map = 0; bf16* WT = nullptr;
        TRJ(5, D, FF, WS_WUPA, MAP_UP1)
        TRJ(6, D, FF, WS_WUPA, MAP_UP3)
        TRJ(7, FF, D, WS_WDNA, MAP_PLAIN)
        TRJ(9, D, NIN, WS_WIN, MAP_WIN)
        TRJ(11, D, D, WS_WC, MAP_PLAIN)
        TRJ(20, SW, SW, WS_WG, MAP_PLAIN)
        TRJ(21, SW, D, WS_WS, MAP_PLAIN)
        TRJ(22, D, D, WS_WO, MAP_PLAIN)
        TRJ(24, D, FF, WS_WUPB, MAP_UP1)
        TRJ(25, D, FF, WS_WUPB, MAP_UP3)
        TRJ(26, FF, D, WS_WDNB, MAP_PLAIN)
        const int nbn = N / 32, kb = r / nbn, nb = r % nbn;
        tr_item(W, K, N, 64 * kb, 32 * nb, WT, map_row(map, 32 * nb), scr, lane);
    }
#undef TRJ
}

__device__ __forceinline__ void norm_phase(const float* X, const float* gvec, const float* modsh, const float* modsc, bf16* outb, float* outf, int gw, int NGW, int lane) {
    for (int r0 = gw * 32; r0 < M; r0 += NGW * 32) {
        const int b = r0 / SEQ;
        f32x4 scl[4], sft[4];
#pragma unroll
        for (int j = 0; j < 4; ++j) {
            const f32x4 gg = *(const f32x4*)(gvec + 4 * lane + 256 * j);
            if (modsh) { const f32x4 s1 = *(const f32x4*)(modsc + (size_t)b * NMODC + 4 * lane + 256 * j); scl[j] = gg * (s1 + 1.0f); sft[j] = *(const f32x4*)(modsh + (size_t)b * NMODC + 4 * lane + 256 * j); }
            else { scl[j] = gg; sft[j] = (f32x4){0.f, 0.f, 0.f, 0.f}; }
        }
#pragma unroll 1
        for (int rr = 0; rr < 32; rr += 4) {
            asm volatile("" ::: "memory");
            f32x4 v[4][4];
#pragma unroll
            for (int q = 0; q < 4; ++q)
#pragma unroll
                for (int j = 0; j < 4; ++j) v[q][j] = *(const f32x4*)(X + (size_t)(r0 + rr + q) * D + 4 * lane + 256 * j);
#pragma unroll
            for (int q = 0; q < 4; ++q) {
                float s = 0.f;
#pragma unroll
                for (int j = 0; j < 4; ++j) s += (v[q][j].x * v[q][j].x + v[q][j].y * v[q][j].y) + (v[q][j].z * v[q][j].z + v[q][j].w * v[q][j].w);
                s = wave_sum(s);
                const float rstd = 1.0f / sqrtf(s * (1.0f / D) + EPS);
                const size_t ro = (size_t)(r0 + rr + q) * D + 4 * lane;
#pragma unroll
                for (int j = 0; j < 4; ++j) {
                    const f32x4 o = v[q][j] * rstd * scl[j] + sft[j];
                    if (outb) { u32x2 w; w.x = pk2(o.x, o.y); w.y = pk2(o.z, o.w); *(u32x2*)(outb + ro + 256 * j) = w; }
                    else *(f32x4*)(outf + ro + 256 * j) = o;
                }
            }
        }
    }
}

__device__ __forceinline__ void ssm_job(int job, LAS unsigned char* wl, const bf16* U, bf16* S, const float* abar, const bf16* Bmat, const bf16* CmT, const float* dskip, int lane) {
    const int b = job >> 5, g = job & 31;
    const int l31 = lane & 31, h5 = lane >> 5, l15 = lane & 15, q4 = lane >> 4;
    bf16x8 Bf[4], Cf[4];
#pragma unroll
    for (int nb = 0; nb < 4; ++nb) Bf[nb] = *(const bf16x8*)(Bmat + ((size_t)(g * 128 + 32 * nb + l31) * 16 + 8 * h5));
#pragma unroll
    for (int kb = 0; kb < 4; ++kb) Cf[kb] = *(const bf16x8*)(CmT + ((size_t)(g * 16 + l15) * 128 + 32 * kb + 8 * q4));
    const f32x2 ab = *(const f32x2*)(abar + 2 * (g * 64 + lane));
    const float dsk = dskip[16 * g + l15];
    float xr = 0.f, xi = 0.f;
    LAS float* Bu = (LAS float*)wl;
    LAS unsigned* Xs = (LAS unsigned*)(wl + 16384);
    const bf16* Ub = U + (size_t)b * SEQ * SW + 16 * g;
    bf16* Sb = S + (size_t)b * SEQ * SW + 16 * g;
    bf16x8 Af = *(const bf16x8*)(Ub + (size_t)l31 * SW + 8 * h5);
    for (int ch = 0; ch < SEQ / 32; ++ch) {
        const int t0 = ch * 32;
        bf16x8 Afn = Af;
        if (ch + 1 < SEQ / 32) Afn = *(const bf16x8*)(Ub + (size_t)(t0 + 32 + l31) * SW + 8 * h5);
        bf16 uu[2][4];
#pragma unroll
        for (int mb = 0; mb < 2; ++mb)
#pragma unroll
            for (int r = 0; r < 4; ++r) uu[mb][r] = Ub[(size_t)(t0 + 16 * mb + 4 * q4 + r) * SW + l15];
#pragma unroll
        for (int nb = 0; nb < 4; ++nb) {
            f32x16 c;
#pragma unroll
            for (int r = 0; r < 16; ++r) c[r] = 0.f;
            c = __builtin_amdgcn_mfma_f32_32x32x16_bf16(Af, Bf[nb], c, 0, 0, 0);
#pragma unroll
            for (int r = 0; r < 16; ++r) Bu[((r & 3) + 8 * (r >> 2) + 4 * h5) * 128 + 32 * nb + l31] = c[r];
        }
        LDS_WAIT();
#pragma unroll 8
        for (int t = 0; t < 32; ++t) {
            const f32x2 bu = *(const LAS f32x2*)(Bu + t * 128 + 2 * lane);
            const float nr = __builtin_fmaf(ab.x, xr, __builtin_fmaf(-ab.y, xi, bu.x));
            const float ni = __builtin_fmaf(ab.x, xi, __builtin_fmaf(ab.y, xr, bu.y));
            xr = nr; xi = ni;
            Xs[t * 68 + lane] = pk2(nr, ni);
        }
        LDS_WAIT();
        f32x4 y[2];
#pragma unroll
        for (int mb = 0; mb < 2; ++mb) {
            y[mb] = (f32x4){0.f, 0.f, 0.f, 0.f};
#pragma unroll
            for (int kb = 0; kb < 4; ++kb) {
                const bf16x8 xa = *(const LAS bf16x8*)((const LAS unsigned char*)Xs + (16 * mb + l15) * 272 + (32 * kb + 8 * q4) * 2);
                y[mb] = __builtin_amdgcn_mfma_f32_16x16x32_bf16(xa, Cf[kb], y[mb], 0, 0, 0);
            }
        }
#pragma unroll
        for (int mb = 0; mb < 2; ++mb)
#pragma unroll
            for (int r = 0; r < 4; ++r) {
                const float s = y[mb][r] + dsk * bf2f(uu[mb][r]);
                Sb[(size_t)(t0 + 16 * mb + 4 * q4 + r) * SW + l15] = (bf16)(pk2(fgelu_tanh(s), 0.f) & 0xffffu);
            }
        LDS_WAIT();
        Af = Afn;
    }
}

__device__ __forceinline__ void conv_job(int j, const bf16* Z, const bf16* GB, bf16* YA, const float* cwt, int lane) {
    const int b = j >> 7, rem = j & 127, tb = rem >> 1, half = rem & 1;
    const int col = half * 512 + lane * 8;
    float w0[8], w1[8], w2[8];
#pragma unroll
    for (int i = 0; i < 8; ++i) { w0[i] = cwt[col + i]; w1[i] = cwt[D + col + i]; w2[i] = cwt[2 * D + col + i]; }
    const size_t rowbase = (size_t)b * SEQ + tb * 32;
    float z2[8], z1[8];
#pragma unroll
    for (int i = 0; i < 8; ++i) { z2[i] = 0.f; z1[i] = 0.f; }
    if (tb > 0) { unpack8(*(const u32x4*)(Z + (rowbase - 2) * D + col), z2); unpack8(*(const u32x4*)(Z + (rowbase - 1) * D + col), z1); }
#pragma unroll 4
    for (int t = 0; t < 32; ++t) {
        float zc[8], gb[8], o[8];
        unpack8(*(const u32x4*)(Z + (rowbase + t) * D + col), zc);
        unpack8(*(const u32x4*)(GB + (rowbase + t) * D + col), gb);
#pragma unroll
        for (int i = 0; i < 8; ++i) { o[i] = gb[i] * (w0[i] * z2[i] + w1[i] * z1[i] + w2[i] * zc[i]); z2[i] = z1[i]; z1[i] = zc[i]; }
        *(u32x4*)(YA + (rowbase + t) * D + col) = pack8(o);
    }
}

#ifndef REPEAT_PH
#define REPEAT_PH -1
#endif
#ifndef PROBE_A
#define PROBE_A -1
#define PROBE_B -1
#endif
constexpr int NPH = 15;
__global__ void __launch_bounds__(NTHR, 2) fwd_kernel(Args a) {
    extern __shared__ __attribute__((aligned(16))) unsigned char lds_raw[];
    LAS unsigned char* lds = (LAS unsigned char*)lds_raw;
    const int tid0 = threadIdx.x;
    const int G = gridDim.x, bid0 = blockIdx.x;
    unsigned char* ws0 = a.ws;
    volatile LAS unsigned* MISC = (volatile LAS unsigned*)(lds + 131072 + 320);
    if (tid0 < 32) MISC[tid0] = 0u;
    __syncthreads();
    const XcdBarrier xbar = xcd_barrier_post((unsigned*)(ws0 + WS_BAR), MISC + 8);

    bool repeated = false; (void)repeated;
#pragma unroll 1
    for (int ph = a.ph_lo; ph < a.ph_hi; ++ph) {
        int tid = tid0, bid = bid0; unsigned char* ws = ws0;
        asm volatile("" : "+v"(tid)); asm volatile("" : "+s"(bid)); asm volatile("" : "+s"(ws));
        const int lane = tid & 63, wave = __builtin_amdgcn_readfirstlane(tid >> 6);
        const int gw = bid * NWAVES + wave, NGW = G * NWAVES;
        float* mod = (float*)(ws + WS_MOD);
        float* X1 = (float*)(ws + WS_X1);
        float* X2 = a.out;
        bf16* XN = (bf16*)(ws + WS_XN); bf16* HB = (bf16*)(ws + WS_HB);
        bf16* Zb = (bf16*)a.out; bf16* GBb = (bf16*)a.out + (size_t)M * D;
        bf16* Ub = (bf16*)(ws + WS_U); bf16* SAb = (bf16*)(ws + WS_SA); bf16* SBb = (bf16*)(ws + WS_SB);
        bf16* Sb = (bf16*)(ws + WS_S); bf16* S2b = (bf16*)(ws + WS_S2); bf16* YAb = (bf16*)(ws + WS_YA);
#if PROBE_A >= 0
        if (bid == 0 && tid == 0) ((unsigned long long*)(ws + 65536))[ph] = __builtin_amdgcn_s_memrealtime();
#endif
        bool is_gemm = false, sync_after = true;
        pg8::Gemm g{nullptr, nullptr, M, 0, 0};
        Epi E{};
        switch (ph) {
        case 0: prologue(a, lds, tid, lane, wave, bid, G); break;
        case 1: norm_phase(a.in[0], a.in[4], mod + 0 * D, mod + 1 * D, XN, nullptr, gw, NGW, lane); break;
        case 2: is_gemm = true; g.A = XN; g.Bt = (const bf16*)(ws + WS_WUPA); g.N = NUP; g.K = D; E.mode = EM_SWIGLU; E.O = HB; E.ldc = FF; break;
        case 3: is_gemm = true; g.A = HB; g.Bt = (const bf16*)(ws + WS_WDNA); g.N = D; g.K = FF; E.mode = EM_RES; E.base = a.in[0]; E.outf = X1; E.gate = mod + 2 * D; E.coef = 0.5f; break;
        case 4: norm_phase(X1, a.in[8], mod + 3 * D, mod + 4 * D, XN, nullptr, gw, NGW, lane); break;
        case 5: is_gemm = true; g.A = XN; g.Bt = (const bf16*)(ws + WS_WIN); g.N = NIN; g.K = D; E.mode = EM_WIN; E.O = GBb; E.O2 = Zb; E.O3 = Ub; E.O4 = SAb; E.O5 = SBb; break;
        case 6: {
            if (wave < 4) {
                for (int job = bid * 4 + wave; job < BATCH * 32; job += G * 4)
                    ssm_job(job, lds + wave * 32768, Ub, Sb, (const float*)(ws + WS_ABAR), (const bf16*)(ws + WS_BMAT), (const bf16*)(ws + WS_CMAT), a.in[19], lane);
            } else {
                for (int j = bid * 4 + (wave - 4); j < BATCH * 128; j += G * 4) conv_job(j, Zb, GBb, YAb, a.in[10], lane);
            }
        } break;
        case 7: is_gemm = true; sync_after = false; g.A = YAb; g.Bt = (const bf16*)(ws + WS_WC); g.N = D; g.K = D; E.mode = EM_MULA; E.O = SAb; E.P = SAb; E.ldc = D; break;
        case 8: is_gemm = true; g.A = Sb; g.Bt = (const bf16*)(ws + WS_WG); g.N = SW; g.K = SW; E.mode = EM_GLU; E.O = S2b; E.P = Sb; E.ldc = SW; break;
        case 9: is_gemm = true; g.A = S2b; g.Bt = (const bf16*)(ws + WS_WS); g.N = D; g.K = SW; E.mode = EM_MERGE; E.O = SAb; E.P = SAb; E.Q = SBb; E.ldc = D; break;
        case 10: is_gemm = true; g.A = SAb; g.Bt = (const bf16*)(ws + WS_WO); g.N = D; g.K = D; E.mode = EM_RES; E.base = X1; E.outf = X2; E.gate = mod + 5 * D; E.coef = 1.0f; break;
        case 11: norm_phase(X2, a.in[23], mod + 6 * D, mod + 7 * D, XN, nullptr, gw, NGW, lane); break;
        case 12: is_gemm = true; g.A = XN; g.Bt = (const bf16*)(ws + WS_WUPB); g.N = NUP; g.K = D; E.mode = EM_SWIGLU; E.O = HB; E.ldc = FF; break;
        case 13: is_gemm = true; g.A = HB; g.Bt = (const bf16*)(ws + WS_WDNB); g.N = D; g.K = FF; E.mode = EM_RES; E.base = X2; E.outf = X1; E.gate = mod + 8 * D; E.coef = 0.5f; break;
        case 14: norm_phase(X1, a.in[27], nullptr, nullptr, nullptr, a.out, gw, NGW, lane); break;
#if PROBE_A >= 0
        case 15: {
            const unsigned long long* ts = (const unsigned long long*)(ws + 65536);
            const float e1 = (float)(ts[PROBE_A + 1] - ts[PROBE_A]) * 1e-4f, e2 = (float)(ts[PROBE_B + 1] - ts[PROBE_B]) * 1e-5f;
            for (size_t i = (size_t)bid * NTHR + tid; i < (size_t)(1u << 22); i += (size_t)G * NTHR) a.out[i] += e2;
            if (bid == 0 && tid == 0) a.out[(1u << 22) + 5] += e1;
        } break;
#endif
        default: break;
        }
        if (is_gemm) {
            pg8::StaticOrder S; S.init(g.M, g.N, G, bid);
            pg8::gemm_phase<Epi, pg8::StaticOrder, true, true>(lds, g, S, E);
        }
        if (ph + 1 < a.ph_hi && sync_after) { if (ph == 0) cg::this_grid().sync(); else xcd_barrier(xbar); }
#if REPEAT_PH >= 0
        if (ph == REPEAT_PH && !repeated) { repeated = true; if (!sync_after || ph + 1 >= a.ph_hi) cg::this_grid().sync(); --ph; }
#endif
    }
}

#ifndef MK_MULTI
#define MK_MULTI 0
#endif
extern "C" void kernel_launch(void* const* d_in, const int* in_sizes, int n_in, void* d_out, int out_size, void* d_ws, size_t ws_size, hipStream_t stream) {
    static int grid = 0;
    if (grid == 0) {
        if (n_in != 28 || in_sizes[0] != M * D || out_size != M * D || ws_size < WS_END) { fprintf(stderr, "kernel_launch: unexpected shapes (n_in %d, in0 %d, out %d, ws %zu)\n", n_in, n_in > 0 ? in_sizes[0] : -1, out_size, ws_size); grid = -1; return; }
        int dev = 0, cus = 0, per_cu = 0;
        if (hipGetDevice(&dev) != hipSuccess || hipDeviceGetAttribute(&cus, hipDeviceAttributeMultiprocessorCount, dev) != hipSuccess) { grid = -1; return; }
        if (hipFuncSetAttribute((const void*)fwd_kernel, hipFuncAttributeMaxDynamicSharedMemorySize, LDS_BYTES) != hipSuccess) { fprintf(stderr, "kernel_launch: hipFuncSetAttribute failed\n"); grid = -1; return; }
        if (hipOccupancyMaxActiveBlocksPerMultiprocessor(&per_cu, (const void*)fwd_kernel, NTHR, LDS_BYTES) != hipSuccess || per_cu < 1) { fprintf(stderr, "kernel_launch: occupancy query says %d\n", per_cu); per_cu = 1; }
        (void)hipGetLastError();
        grid = cus * per_cu;
        fprintf(stderr, "kernel_launch: grid %d (cus %d x %d)\n", grid, cus, per_cu);
    }
    if (grid < 0) return;
    if (hipMemsetAsync((char*)d_ws + WS_BAR, 0, WS_BAR_BYTES, stream) != hipSuccess) { fprintf(stderr, "kernel_launch: memset failed\n"); return; }
    Args a{};
    for (int i = 0; i < 28; ++i) a.in[i] = (const float*)d_in[i];
    a.out = (float*)d_out; a.ws = (unsigned char*)d_ws;
#if MK_MULTI
    for (int ph = 0; ph < NPH; ++ph) { a.ph_lo = ph; a.ph_hi = ph + 1; hipLaunchKernelGGL(fwd_kernel, dim3(grid), dim3(NTHR), LDS_BYTES, stream, a); }
#else
    a.ph_lo = 0; a.ph_hi = NPH + (PROBE_A >= 0 ? 1 : 0);
    void* kargs[] = {(void*)&a};
    hipError_t e = hipLaunchCooperativeKernel((const void*)fwd_kernel, dim3(grid), dim3(NTHR), kargs, LDS_BYTES, stream);
    if (e != hipSuccess) fprintf(stderr, "kernel_launch: cooperative launch failed: %s (grid %d)\n", hipGetErrorString(e), grid);
#endif
}
```

```cpp
#include <hip/hip_runtime.h>
#include <hip/hip_cooperative_groups.h>
#include <cstdio>
#include <cstdint>
namespace cg = cooperative_groups;
namespace pg8 {
#define PG8_LAS __attribute__((address_space(3)))
typedef unsigned short bf16_t;
typedef short bf16x8 __attribute__((ext_vector_type(8)));
typedef float f32x4 __attribute__((ext_vector_type(4)));
typedef unsigned u32x4 __attribute__((ext_vector_type(4)));
constexpr int BM = 256, BK = 64, HALF = 128, HTB = HALF * BK * 2  , STAGE_BYTES = 8 * HTB, NXCD = 8, WGM = 8;

__host__ __device__ __forceinline__ int lds_byte(int r, int c) { const int st = (r >> 4) * 2 + (c >> 5), rr = r & 15, cc = c & 31, ob = rr * 64 + cc * 2; return st * 1024 + (ob ^ (((ob >> 9) & 1) << 5)); }
__host__ __device__ __forceinline__ void stage_rc(int b, int& R, int& C) { const int st = b / 1024, sb = b % 1024, swz = sb ^ (((sb >> 9) & 1) << 5); R = (st >> 1) * 16 + swz / 64; C = (st & 1) * 32 + (swz % 64) / 2; }
__host__ __device__ __forceinline__ int perm32(int rho) { const int n = rho >> 4, i = rho & 15; return 8 * (i >> 2) + 4 * n + (i & 3); }

struct Unit { int pm, pn; };
struct Gemm { const bf16_t* A; const bf16_t* Bt; int M, N, K; };

struct StaticOrder {
    int nM, nN, nwg, G, c;
    __host__ __device__ void init(int M, int N, int G_, int c_) { nM = M / BM; nN = N / BM; nwg = nM * nN; G = G_; c = c_; }
    __host__ __device__ bool next(int i, Unit& u) const {
        const long L = (long)i * G + c; if (L >= nwg) return false;
        int wgid = (int)L; { const int q = nwg / NXCD, r = nwg % NXCD, xcd = wgid % NXCD, off = wgid / NXCD; wgid = (xcd < r ? xcd * (q + 1) : r * (q + 1) + (xcd - r) * q) + off; }
        const int nig = WGM * nN, gid = wgid / nig, fm = gid * WGM, gsz = (nM - fm) < WGM ? (nM - fm) : WGM;
        u.pm = fm + ((wgid % nig) % gsz); u.pn = (wgid % nig) / gsz; return true;
    }
    __device__ __forceinline__ void a_ready(const Unit&) const {}
    __device__ __forceinline__ void done(const Unit&) const {}
};

__device__ __forceinline__ unsigned cvt_pk_bf16(float lo, float hi) { unsigned r; asm volatile("v_cvt_pk_bf16_f32 %0, %1, %2" : "=v"(r) : "v"(lo), "v"(hi)); return r; }
template <class Epi, class Sched, bool ALIGN_EPI = false, bool SP2 = false>
__device__ __forceinline__ void gemm_phase(PG8_LAS unsigned char* lds, const Gemm g, const Sched& S, const Epi& E) {
    const int tid = threadIdx.x, wid = __builtin_amdgcn_readfirstlane(tid >> 6), lane = tid & 63, wr = wid >> 2, wc = wid & 3, fr = lane & 15, fq = lane >> 4;
    const int K = g.K, nt = K / BK;
    unsigned voffA[2], voffB[2];
#pragma unroll
    for (int i = 0; i < 2; ++i) { int R, C; stage_rc(tid * 16 + i * 8192, R, C); const int Rb = Epi::PERM ? ((R & ~31) + perm32(R & 31)) : R;
        voffA[i] = (unsigned)(R * K + C) * 2u; voffB[i] = (unsigned)(Rb * K + C) * 2u; }
    const size_t kstep = (size_t)(BK * 2);
    const size_t hstep = (size_t)HALF * K * 2;
    const size_t tstep = 2 * hstep;
    const unsigned ldsw = (unsigned)wid * 1024u;
    const int aoff = lds_byte(wr * 64 + fr, fq * 8), boff = lds_byte(wc * 32 + fr, fq * 8);
#define PG8_SA(b, h) (((b) * 2 + (h)) * HTB)
#define PG8_SB(b, h) ((4 + (b) * 2 + (h)) * HTB)
#define PG8_STAGE(bufoff, gbase, voff) do { _Pragma("unroll") for (int _i = 0; _i < 2; ++_i) \
        __builtin_amdgcn_global_load_lds((const unsigned*)((const char*)(gbase) + (voff)[_i]), (PG8_LAS unsigned*)(lds + (bufoff) + ldsw + _i * 8192), 16, 0, 0); } while (0)
#define PG8_LDA(dst, b, h) do { _Pragma("unroll") for (int m = 0; m < 4; ++m) _Pragma("unroll") for (int k = 0; k < 2; ++k) dst[m][k] = *(const PG8_LAS bf16x8*)(lds + PG8_SA(b, h) + aoff + m * 2048 + k * 1024); } while (0)
#define PG8_LDB(dst, b, h) do { _Pragma("unroll") for (int n = 0; n < 2; ++n) _Pragma("unroll") for (int k = 0; k < 2; ++k) dst[n][k] = *(const PG8_LAS bf16x8*)(lds + PG8_SB(b, h) + boff + n * 2048 + k * 1024); } while (0)
#define PG8_MMA(ai, bj, At, Bt) do { __builtin_amdgcn_s_setprio(1); _Pragma("unroll") for (int m = 0; m < 4; ++m) _Pragma("unroll") for (int n = 0; n < 2; ++n) _Pragma("unroll") for (int k = 0; k < 2; ++k) \
        acc[ai][bj][m][n] = __builtin_amdgcn_mfma_f32_16x16x32_bf16(Bt[n][k], At[m][k], acc[ai][bj][m][n], 0, 0, 0); __builtin_amdgcn_s_setprio(0); } while (0)
#define PG8_WAIT_V(n) asm volatile("s_waitcnt vmcnt(" #n ")" ::: "memory")
#define PG8_WAIT_L(n) asm volatile("s_waitcnt lgkmcnt(" #n ")" ::: "memory")
#define PG8_BAR __builtin_amdgcn_s_barrier()
#define PG8_SCHED __builtin_amdgcn_sched_barrier(0)
    Unit cur, nxt; int ui = 0;
    if (!S.next(0, cur)) return;
    f32x4 acc[2][2][4][2];
#pragma unroll
    for (int a = 0; a < 2; ++a)
#pragma unroll
        for (int b = 0; b < 2; ++b)
#pragma unroll
            for (int m = 0; m < 4; ++m)
#pragma unroll
                for (int n = 0; n < 2; ++n) acc[a][b][m][n] = (f32x4){0.f, 0.f, 0.f, 0.f};
    bf16x8 At[4][2], B0[2][2], B1[2][2];
    const char* cA = (const char*)g.A + (size_t)cur.pm * tstep; const char* cB = (const char*)g.Bt + (size_t)cur.pn * tstep;
    S.a_ready(cur);
    if constexpr (SP2) {
        PG8_STAGE(PG8_SB(0, 0), cB, voffB); PG8_STAGE(PG8_SB(0, 1), cB + hstep, voffB); PG8_STAGE(PG8_SA(0, 0), cA, voffA); PG8_STAGE(PG8_SA(0, 1), cA + hstep, voffA);
        if (wr == 1) PG8_BAR;
        PG8_WAIT_V(2); PG8_BAR;
        PG8_STAGE(PG8_SB(1, 0), cB + kstep, voffB); PG8_STAGE(PG8_SA(1, 0), cA + kstep, voffA); PG8_STAGE(PG8_SB(1, 1), cB + hstep + kstep, voffB);
        PG8_WAIT_V(6); PG8_BAR;
    } else {
        PG8_STAGE(PG8_SB(0, 0), cB, voffB); PG8_STAGE(PG8_SA(0, 0), cA, voffA); PG8_STAGE(PG8_SB(0, 1), cB + hstep, voffB); PG8_STAGE(PG8_SA(0, 1), cA + hstep, voffA);
        if (wr == 1) PG8_BAR;
        PG8_WAIT_V(4); PG8_BAR;
        PG8_STAGE(PG8_SB(1, 0), cB + kstep, voffB); PG8_STAGE(PG8_SA(1, 0), cA + kstep, voffA); PG8_STAGE(PG8_SB(1, 1), cB + hstep + kstep, voffB);
        PG8_WAIT_V(6); PG8_BAR;
    }
    for (;;) {
        const bool has_next = S.next(ui + 1, nxt);
        const char* nA = has_next ? (const char*)g.A + (size_t)nxt.pm * tstep : cA; const char* nB = has_next ? (const char*)g.Bt + (size_t)nxt.pn * tstep : cB;
        for (int t = 0; t < nt; t += 2) {
            const bool last = (t == nt - 2);
            const char* a1 = cA + (size_t)(t + 1) * kstep;
            const char* a2 = last ? nA : cA + (size_t)(t + 2) * kstep; const char* b2 = last ? nB : cB + (size_t)(t + 2) * kstep;
            const char* a3 = a2 + kstep; const char* b3 = b2 + kstep;
            if (last && has_next) S.a_ready(nxt);
            if constexpr (SP2) {
            PG8_LDB(B0, 0, 0); PG8_LDB(B1, 0, 1); PG8_SCHED; PG8_LDA(At, 0, 0); PG8_STAGE(PG8_SA(1, 1), a1 + hstep, voffA);
            PG8_WAIT_V(8); PG8_WAIT_L(0); PG8_BAR; PG8_MMA(0, 0, At, B0); PG8_MMA(0, 1, At, B1); PG8_BAR; PG8_SCHED;
            PG8_LDA(At, 0, 1); PG8_STAGE(PG8_SB(0, 0), b2, voffB); PG8_STAGE(PG8_SB(0, 1), b2 + hstep, voffB); PG8_STAGE(PG8_SA(0, 0), a2, voffA);
            PG8_WAIT_V(8); PG8_WAIT_L(0); PG8_BAR; PG8_MMA(1, 0, At, B0); PG8_MMA(1, 1, At, B1); PG8_BAR; PG8_SCHED;
            PG8_LDB(B0, 1, 0); PG8_LDB(B1, 1, 1); PG8_SCHED; PG8_LDA(At, 1, 0); PG8_STAGE(PG8_SA(0, 1), a2 + hstep, voffA);
            PG8_WAIT_V(8); PG8_WAIT_L(0); PG8_BAR; PG8_MMA(0, 0, At, B0); PG8_MMA(0, 1, At, B1); PG8_BAR; PG8_SCHED;
            PG8_LDA(At, 1, 1); PG8_STAGE(PG8_SB(1, 0), b3, voffB); PG8_STAGE(PG8_SB(1, 1), b3 + hstep, voffB); PG8_STAGE(PG8_SA(1, 0), a3, voffA);
            PG8_WAIT_V(8); PG8_WAIT_L(0); PG8_BAR; PG8_MMA(1, 0, At, B0); PG8_MMA(1, 1, At, B1); PG8_BAR; PG8_SCHED;
            } else {
            PG8_LDB(B0, 0, 0); PG8_SCHED; PG8_LDA(At, 0, 0); PG8_STAGE(PG8_SA(1, 1), a1 + hstep, voffA);
            PG8_WAIT_L(8); PG8_BAR; PG8_WAIT_L(0); PG8_MMA(0, 0, At, B0); PG8_BAR; PG8_SCHED;
            PG8_LDB(B1, 0, 1); PG8_STAGE(PG8_SB(0, 0), b2, voffB);
            PG8_BAR; PG8_WAIT_L(0); PG8_MMA(0, 1, At, B1); PG8_BAR;
            PG8_LDA(At, 0, 1); PG8_STAGE(PG8_SA(0, 0), a2, voffA);
            PG8_BAR; PG8_WAIT_L(0); PG8_MMA(1, 0, At, B0); PG8_BAR; PG8_SCHED;
            PG8_STAGE(PG8_SB(0, 1), b2 + hstep, voffB);
            PG8_WAIT_V(6); PG8_BAR; PG8_MMA(1, 1, At, B1); PG8_BAR;
            PG8_LDB(B0, 1, 0); PG8_SCHED; PG8_LDA(At, 1, 0); PG8_STAGE(PG8_SA(0, 1), a2 + hstep, voffA);
            PG8_WAIT_L(8); PG8_BAR; PG8_WAIT_L(0); PG8_MMA(0, 0, At, B0); PG8_BAR; PG8_SCHED;
            PG8_LDB(B1, 1, 1); PG8_STAGE(PG8_SB(1, 0), b3, voffB);
            PG8_BAR; PG8_WAIT_L(0); PG8_MMA(0, 1, At, B1); PG8_BAR;
            PG8_LDA(At, 1, 1); PG8_STAGE(PG8_SA(1, 0), a3, voffA);
            PG8_BAR; PG8_WAIT_L(0); PG8_MMA(1, 0, At, B0); PG8_BAR; PG8_SCHED;
            PG8_STAGE(PG8_SB(1, 1), b3 + hstep, voffB);
            PG8_WAIT_V(6); PG8_BAR; PG8_MMA(1, 1, At, B1); PG8_BAR;
            }
        }
        if constexpr (ALIGN_EPI) { if (wr == 0) PG8_BAR; }
        if constexpr (!Epi::AFTER_DRAIN) { E(acc, cur, wr, wc, fr, fq); S.done(cur); }
        if (!has_next) break;
#pragma unroll
        for (int a = 0; a < 2; ++a)
#pragma unroll
            for (int b = 0; b < 2; ++b)
#pragma unroll
                for (int m = 0; m < 4; ++m)
#pragma unroll
                    for (int n = 0; n < 2; ++n) acc[a][b][m][n] = (f32x4){0.f, 0.f, 0.f, 0.f};
        cur = nxt; cA = nA; cB = nB; ++ui;
        if constexpr (ALIGN_EPI) { if (wr == 1) PG8_BAR; }
    }
    PG8_WAIT_V(0);
    if constexpr (!ALIGN_EPI) { if (wr == 0) PG8_BAR; }
    PG8_BAR;
    if constexpr (Epi::AFTER_DRAIN) { E.fused(acc, cur, wr, wc, fr, fq, lds, wid, lane); S.done(cur); }
#undef PG8_SA
#undef PG8_SB
#undef PG8_STAGE
#undef PG8_LDA
#undef PG8_LDB
#undef PG8_MMA
#undef PG8_WAIT_V
#undef PG8_WAIT_L
#undef PG8_BAR
#undef PG8_SCHED
}
}

constexpr int BATCH = 32, SEQ = 2048, D = 1024, M = BATCH * SEQ, FF = 2816, NUP = 2 * FF, NIN = 5632;
constexpr int SW = 512, NMODC = 9 * D;
constexpr float EPS = 1e-6f;
constexpr int NWAVES = 8, NTHR = 512;
constexpr int LDS_BYTES = 147456;
constexpr size_t MiB = 1u << 20;
constexpr size_t WS_BAR = 0, WS_BAR_BYTES = 16384;
constexpr size_t WS_MOD = 1 * MiB, WS_ABAR = 3 * MiB, WS_BMAT = 3 * MiB + 64 * 1024, WS_CMAT = 3 * MiB + 256 * 1024;
constexpr size_t WS_WUPA = 4 * MiB, WS_WDNA = 15 * MiB, WS_WIN = 21 * MiB, WS_WC = 32 * MiB, WS_WG = 34 * MiB, WS_WS = 35 * MiB, WS_WO = 36 * MiB, WS_WUPB = 38 * MiB, WS_WDNB = 49 * MiB;
constexpr size_t WS_X1 = 56 * MiB, WS_XN = 312 * MiB, WS_S = 312 * MiB, WS_S2 = 376 * MiB, WS_HB = 440 * MiB, WS_U = 440 * MiB, WS_SA = 504 * MiB, WS_SB = 632 * MiB, WS_YA = 792 * MiB, WS_TW2 = 920 * MiB, WS_TW3 = 921 * MiB, WS_END = 922 * MiB;
constexpr size_t WS_RS2 = 2 * MiB + 256 * 1024, WS_RS3 = 2 * MiB + 512 * 1024;

#define LAS __attribute__((address_space(3)))
typedef unsigned short bf16;
typedef unsigned u32x4 __attribute__((ext_vector_type(4)));
typedef unsigned u32x2 __attribute__((ext_vector_type(2)));
typedef float f32x4 __attribute__((ext_vector_type(4)));
typedef float f32x2 __attribute__((ext_vector_type(2)));
typedef float f32x16 __attribute__((ext_vector_type(16)));
typedef short bf16x8 __attribute__((ext_vector_type(8)));
#define LDS_WAIT() asm volatile("s_waitcnt lgkmcnt(0)" ::: "memory")

__device__ __forceinline__ unsigned pk2(float lo, float hi) { return pg8::cvt_pk_bf16(lo, hi); }
__device__ __forceinline__ float bflo(unsigned w) { return __uint_as_float(w << 16); }
__device__ __forceinline__ float bfhi(unsigned w) { return __uint_as_float(w & 0xffff0000u); }
__device__ __forceinline__ float bf2f(bf16 v) { return __uint_as_float((unsigned)v << 16); }
__device__ __forceinline__ float fsigmoid(float x) { return __builtin_amdgcn_rcpf(1.0f + __builtin_amdgcn_exp2f(-1.44269504f * x)); }
__device__ __forceinline__ float fsilu(float x) { return x * fsigmoid(x); }
__device__ __forceinline__ float fgelu_tanh(float x) { const float u = x + 0.044715f * x * x * x; return x * __builtin_amdgcn_rcpf(1.0f + __builtin_amdgcn_exp2f(-2.0f * 0.7978845608f * 1.44269504f * u)); }
__device__ __forceinline__ void unpack8(const u32x4 w, float (&f)[8]) { f[0] = bflo(w.x); f[1] = bfhi(w.x); f[2] = bflo(w.y); f[3] = bfhi(w.y); f[4] = bflo(w.z); f[5] = bfhi(w.z); f[6] = bflo(w.w); f[7] = bfhi(w.w); }
__device__ __forceinline__ u32x4 pack8(const float (&f)[8]) { u32x4 w; w.x = pk2(f[0], f[1]); w.y = pk2(f[2], f[3]); w.z = pk2(f[4], f[5]); w.w = pk2(f[6], f[7]); return w; }
__device__ __forceinline__ float wave_sum(float v) {
#pragma unroll
    for (int o = 1; o < 64; o <<= 1) v += __shfl_xor(v, o);
    return v;
}

#define XB_TMO      128
#define XB_XCNT(j)  (256  + 64 * (j))
#define XB_XSUB(j)  (1280 + 64 * (j))
#define XB_XGEN(j)  (2304 + 64 * (j))
#define XB_TOP      3328
#define XB_TOPGEN   3392
#define XCD_BAR_WORDS 3456
#define XB_SPIN_CAP (1u << 18)

__device__ __forceinline__ unsigned xb_ld(unsigned* p)              { return __hip_atomic_load(p, __ATOMIC_RELAXED, __HIP_MEMORY_SCOPE_AGENT); }
__device__ __forceinline__ unsigned xb_add(unsigned* p, unsigned v) { return __hip_atomic_fetch_add(p, v, __ATOMIC_RELAXED, __HIP_MEMORY_SCOPE_AGENT); }
__device__ __forceinline__ unsigned xb_xcc_id() { return (unsigned)__builtin_amdgcn_s_getreg((3 << 11) | 20) & 0xFu; }
#define XB_SPIN(cond, bar) do { unsigned _sp = 0; while (cond) { __builtin_amdgcn_s_sleep(1); \
    if ((++_sp & 255u) == 0u) { if (xb_ld(&(bar)[XB_TMO])) break; if (_sp > XB_SPIN_CAP) { atomicAdd(&(bar)[XB_TMO], 1u); break; } } } } while (0)

struct XcdBarrier {
    unsigned* bar; unsigned x;
    volatile LAS unsigned* st;
};

__device__ __forceinline__ XcdBarrier xcd_barrier_post(unsigned* bar, volatile LAS unsigned* st) {
    XcdBarrier b; b.bar = bar; b.x = xb_xcc_id(); b.st = st;
    if (threadIdx.x == 0) (void)xb_add(&bar[XB_XCNT(b.x)], 1u);
    return b;
}
__device__ __forceinline__ void xcd_barrier_complete(unsigned* bar, unsigned x, unsigned& nloc, unsigned& nx) {
    const unsigned G = gridDim.x * gridDim.y * gridDim.z;
    unsigned sum, cnt, mine, sp = 0u;
    for (;;) {
        sum = 0u; cnt = 0u; mine = 0u;
#pragma unroll
        for (unsigned j = 0; j < 16; ++j) { const unsigned c = xb_ld(&bar[XB_XCNT(j)]); sum += c; cnt += (c > 0u) ? 1u : 0u; mine = (j == x) ? c : mine; }
        if (sum == G) break;
        __builtin_amdgcn_s_sleep(1);
        if ((++sp & 255u) == 0u) { if (xb_ld(&bar[XB_TMO])) break; if (sp > XB_SPIN_CAP) { atomicAdd(&bar[XB_TMO], 1u); break; } }
    }
    nloc = mine > 0u ? mine : 1u; nx = cnt > 0u ? cnt : 1u;
}

__device__ __forceinline__ void xcd_barrier(const XcdBarrier& b) {
    asm volatile("s_waitcnt vmcnt(0)" ::: "memory");
    __syncthreads();
    if (threadIdx.x == 0) {
        unsigned* bar = b.bar;
        __builtin_amdgcn_s_waitcnt(0);
        unsigned nloc = b.st[0], nx = b.st[1];
        if (nloc == 0u) { xcd_barrier_complete(bar, b.x, nloc, nx); b.st[0] = nloc; b.st[1] = nx; }
        const unsigned old = xb_add(&bar[XB_XSUB(b.x)], 1u);
        const unsigned gen = old / nloc;
        if (old + 1u == (gen + 1u) * nloc) {
            __builtin_amdgcn_fence(__ATOMIC_RELEASE, "agent");
            asm volatile("s_waitcnt vmcnt(0)" ::: "memory");
            const unsigned og = xb_add(&bar[XB_TOP], 1u);
            const unsigned tg = og / nx;
            if (og + 1u == (tg + 1u) * nx) xb_add(&bar[XB_TOPGEN], 1u);
            else XB_SPIN(xb_ld(&bar[XB_TOPGEN]) == tg, bar);
            __builtin_amdgcn_fence(__ATOMIC_ACQUIRE, "agent");
            xb_add(&bar[XB_XGEN(b.x)], 1u);
            asm volatile("s_waitcnt vmcnt(0)" ::: "memory");
        } else {
            XB_SPIN(xb_ld(&bar[XB_XGEN(b.x)]) == gen, bar);
            __builtin_amdgcn_fence(__ATOMIC_ACQUIRE, "agent");
            asm volatile("s_waitcnt vmcnt(0)" ::: "memory");
        }
    }
    __syncthreads();
}

enum { EM_SWIGLU = 0, EM_RES = 1, EM_WIN = 2, EM_MULA = 3, EM_GLU = 4, EM_MERGE = 5 };
struct Epi {
    static constexpr bool PERM = true, AFTER_DRAIN = false;
    int mode, variant;
    unsigned char* ws; float* dout; const float* xin; const float* gvec;
    __device__ __forceinline__ void operator()(const f32x4 (&acc)[2][2][4][2], const pg8::Unit& u, int wr, int wc, int fr, int fq) const {
        float* const modp = (float*)(ws + WS_MOD);
        bf16* O = nullptr; int ldc = D; bf16 *O2 = nullptr, *O3 = nullptr, *O4 = nullptr, *O5 = nullptr; const bf16 *P = nullptr, *Q = nullptr;
        const float* base = nullptr; const bf16* baseb = nullptr; float* outf = nullptr; bf16* outb = nullptr; const float* gate = nullptr; float coef = 1.0f;
        const float *rs = nullptr, *tw = nullptr; float* rs_out = nullptr; bf16* XA = nullptr; const float* scn = nullptr;
        if (mode == EM_SWIGLU) { O = (bf16*)(ws + WS_HB); ldc = FF; if (variant) { rs = (const float*)(ws + WS_RS3); tw = (const float*)(ws + WS_TW3); } }
        else if (mode == EM_RES) {
            if (variant == 0) { base = xin; outb = (bf16*)(ws + WS_X1); gate = modp + 2 * D; coef = 0.5f; rs_out = (float*)(ws + WS_RS2); XA = (bf16*)(ws + WS_XN); scn = modp + 4 * D; }
            else if (variant == 1) { baseb = (const bf16*)(ws + WS_X1); outb = (bf16*)dout; gate = modp + 5 * D; coef = 1.0f; rs_out = (float*)(ws + WS_RS3); XA = (bf16*)(ws + WS_XN); scn = modp + 7 * D; }
            else { baseb = (const bf16*)dout; outf = (float*)(ws + WS_X1); gate = modp + 8 * D; coef = 0.5f; }
        } else if (mode == EM_WIN) { rs = (const float*)(ws + WS_RS2); tw = (const float*)(ws + WS_TW2); O = (bf16*)dout + (size_t)M * D; O2 = (bf16*)dout; O3 = (bf16*)(ws + WS_U); O4 = (bf16*)(ws + WS_SA); O5 = (bf16*)(ws + WS_SB); }
        else if (mode == EM_MULA) { O = (bf16*)(ws + WS_SA); P = O; }
        else if (mode == EM_GLU) { O = (bf16*)(ws + WS_S2); P = (const bf16*)(ws + WS_S); ldc = SW; }
        else { O = (bf16*)(ws + WS_SA); P = O; Q = (const bf16*)(ws + WS_SB); }
        const int row0 = u.pm * 256 + wr * 64 + fr;
        const int cw = wc * 32 + 8 * fq;
        if (mode < 0) return;
        f32x4 twv[2][2];
#pragma unroll
        for (int bj = 0; bj < 2; ++bj)
#pragma unroll
            for (int n = 0; n < 2; ++n) twv[bj][n] = (f32x4){0.f, 0.f, 0.f, 0.f};
        if (tw) {
            const float* tp = tw + (size_t)(u.pm >> 3) * NIN + u.pn * 256 + cw;
#pragma unroll
            for (int bj = 0; bj < 2; ++bj)
#pragma unroll
                for (int n = 0; n < 2; ++n) twv[bj][n] = *(const f32x4*)(tp + bj * 128 + 4 * n);
        }
        if (mode == EM_SWIGLU) {
            bf16* bp = O + (size_t)row0 * ldc + u.pn * 128 + cw;
#pragma unroll
            for (int ai = 0; ai < 2; ++ai)
#pragma unroll
                for (int m = 0; m < 4; ++m) {
                    const float rstd = rs ? __builtin_amdgcn_rsqf(rs[row0 + ai * 128 + m * 16] * (1.0f / D) + EPS) : 1.0f;
                    float o[8];
#pragma unroll
                    for (int n = 0; n < 2; ++n)
#pragma unroll
                        for (int j = 0; j < 4; ++j) o[4 * n + j] = fsilu(rstd * acc[ai][0][m][n][j] + twv[0][n][j]) * (rstd * acc[ai][1][m][n][j] + twv[1][n][j]);
                    *(u32x4*)(bp + (size_t)(ai * 128 + m * 16) * ldc) = pack8(o);
                }
        } else if (mode == EM_RES) {
            const int b = u.pm >> 3;
            const float* gp = gate + (size_t)b * NMODC + u.pn * 256 + cw;
            f32x4 gv[2][2];
#pragma unroll
            for (int bj = 0; bj < 2; ++bj)
#pragma unroll
                for (int n = 0; n < 2; ++n) gv[bj][n] = *(const f32x4*)(gp + bj * 128 + 4 * n) * coef;
            f32x4 sv[2][2];
#pragma unroll
            for (int bj = 0; bj < 2; ++bj)
#pragma unroll
                for (int n = 0; n < 2; ++n) sv[bj][n] = (f32x4){0.f, 0.f, 0.f, 0.f};
            if (XA) {
                const float* sp = scn + (size_t)b * NMODC + u.pn * 256 + cw; const float* gq = gvec + u.pn * 256 + cw;
#pragma unroll
                for (int bj = 0; bj < 2; ++bj)
#pragma unroll
                    for (int n = 0; n < 2; ++n) sv[bj][n] = *(const f32x4*)(gq + bj * 128 + 4 * n) * (*(const f32x4*)(sp + bj * 128 + 4 * n) + 1.0f);
            }
#pragma unroll
            for (int ai = 0; ai < 2; ++ai)
#pragma unroll
                for (int m = 0; m < 4; ++m) {
                    const size_t off = (size_t)(row0 + ai * 128 + m * 16) * D + u.pn * 256 + cw;
                    float ss = 0.f;
#pragma unroll
                    for (int bj = 0; bj < 2; ++bj) {
                        f32x4 o[2];
                        if (variant == 0) { o[0] = *(const f32x4*)(base + off + bj * 128); o[1] = *(const f32x4*)(base + off + bj * 128 + 4); }
                        else { float bb[8]; unpack8(*(const u32x4*)(baseb + off + bj * 128), bb); o[0] = (f32x4){bb[0], bb[1], bb[2], bb[3]}; o[1] = (f32x4){bb[4], bb[5], bb[6], bb[7]}; }
#pragma unroll
                        for (int n = 0; n < 2; ++n) {
                            o[n] = o[n] + gv[bj][n] * acc[ai][bj][m][n];
                            ss += (o[n].x * o[n].x + o[n].y * o[n].y) + (o[n].z * o[n].z + o[n].w * o[n].w);
                        }
                        if (variant == 2) { *(f32x4*)(outf + off + bj * 128) = o[0]; *(f32x4*)(outf + off + bj * 128 + 4) = o[1]; }
                        else { u32x4 w; w.x = pk2(o[0].x, o[0].y); w.y = pk2(o[0].z, o[0].w); w.z = pk2(o[1].x, o[1].y); w.w = pk2(o[1].z, o[1].w); *(u32x4*)(outb + off + bj * 128) = w; }
                        if (XA) {
                            const f32x4 a0 = o[0] * sv[bj][0], a1 = o[1] * sv[bj][1];
                            u32x4 w; w.x = pk2(a0.x, a0.y); w.y = pk2(a0.z, a0.w); w.z = pk2(a1.x, a1.y); w.w = pk2(a1.z, a1.w);
                            *(u32x4*)(XA + off + bj * 128) = w;
                        }
                    }
                    if (rs_out) {
                        ss += __shfl_xor(ss, 16); ss += __shfl_xor(ss, 32);
                        if (fq == 0) atomicAdd(rs_out + row0 + ai * 128 + m * 16, ss);
                    }
                    if (m & 1) asm volatile("" ::: "memory");
                }
        } else if (mode == EM_WIN) {
            const int pn = u.pn;
            if (pn >= 4 && pn < 12) {
                bf16* bp = O2 + (size_t)row0 * D + (pn - 4) * 128 + cw;
#pragma unroll
                for (int ai = 0; ai < 2; ++ai)
#pragma unroll
                    for (int m = 0; m < 4; ++m) {
                        const float rstd = rs ? __builtin_amdgcn_rsqf(rs[row0 + ai * 128 + m * 16] * (1.0f / D) + EPS) : 1.0f;
                        float o[8];
#pragma unroll
                        for (int n = 0; n < 2; ++n)
#pragma unroll
                            for (int j = 0; j < 4; ++j) o[4 * n + j] = (rstd * acc[ai][0][m][n][j] + twv[0][n][j]) * (rstd * acc[ai][1][m][n][j] + twv[1][n][j]);
                        *(u32x4*)(bp + (size_t)(ai * 128 + m * 16) * D) = pack8(o);
                    }
            } else {
                bf16* dst; int ld, colt; bool sig;
                if (pn < 4) { dst = O; ld = D; colt = pn * 256; sig = false; }
                else if (pn < 14) { dst = O3; ld = SW; colt = (pn - 12) * 256; sig = false; }
                else if (pn < 18) { dst = O4; ld = D; colt = (pn - 14) * 256; sig = true; }
                else { dst = O5; ld = D; colt = (pn - 18) * 256; sig = true; }
                bf16* bp = dst + (size_t)row0 * ld + colt + cw;
#pragma unroll
                for (int ai = 0; ai < 2; ++ai)
#pragma unroll
                    for (int m = 0; m < 4; ++m) {
                        const float rstd = rs ? __builtin_amdgcn_rsqf(rs[row0 + ai * 128 + m * 16] * (1.0f / D) + EPS) : 1.0f;
#pragma unroll
                        for (int bj = 0; bj < 2; ++bj) {
                            float o[8];
#pragma unroll
                            for (int n = 0; n < 2; ++n)
#pragma unroll
                                for (int j = 0; j < 4; ++j) { const float v = rstd * acc[ai][bj][m][n][j] + twv[bj][n][j]; o[4 * n + j] = sig ? fsigmoid(v) : v; }
                            *(u32x4*)(bp + (size_t)(ai * 128 + m * 16) * ld + bj * 128) = pack8(o);
                        }
                    }
            }
        } else {
            const size_t off0 = (size_t)row0 * ldc + u.pn * 256 + cw;
#pragma unroll
            for (int ai = 0; ai < 2; ++ai)
#pragma unroll
                for (int m = 0; m < 4; ++m) {
#pragma unroll
                    for (int bj = 0; bj < 2; ++bj) {
                        const size_t off = off0 + (size_t)(ai * 128 + m * 16) * ldc + bj * 128;
                        float p[8], q[8], o[8];
                        unpack8(*(const u32x4*)(P + off), p);
                        if (mode == EM_MERGE) unpack8(*(const u32x4*)(Q + off), q);
#pragma unroll
                        for (int n = 0; n < 2; ++n)
#pragma unroll
                            for (int j = 0; j < 4; ++j) {
                                const float v = acc[ai][bj][m][n][j];
                                o[4 * n + j] = (mode == EM_MULA) ? p[4 * n + j] * v : (mode == EM_GLU) ? p[4 * n + j] * fsigmoid(v) : p[4 * n + j] + q[4 * n + j] * v;
                            }
                        *(u32x4*)(O + off) = pack8(o);
                    }
                    if (m & 1) asm volatile("" ::: "memory");
                }
        }
    }
};

__device__ __forceinline__ void tr_item(const float* W, int K, int N, int k0, int n0, bf16* WT, int drow0, LAS float* scr, int lane) {
#pragma unroll 8
    for (int i = 0; i < 32; ++i) { const int kk = 2 * i + (lane >> 5); scr[kk * 33 + (lane & 31)] = W[(size_t)(k0 + kk) * N + n0 + (lane & 31)]; }
    LDS_WAIT();
    const int c = lane & 7;
#pragma unroll
    for (int j = 0; j < 4; ++j) {
        const int n = (lane >> 3) + 8 * j; const LAS float* s = scr + (8 * c) * 33 + n;
        u32x4 o; o.x = pk2(s[0 * 33], s[1 * 33]); o.y = pk2(s[2 * 33], s[3 * 33]); o.z = pk2(s[4 * 33], s[5 * 33]); o.w = pk2(s[6 * 33], s[7 * 33]);
        *(u32x4*)(WT + (size_t)(drow0 + n) * K + k0 + 8 * c) = o;
    }
    LDS_WAIT();
}
enum { MAP_PLAIN = 0, MAP_UP1 = 1, MAP_UP3 = 2, MAP_WIN = 3 };
__device__ __forceinline__ int map_row(int map, int n0) {
    if (map == MAP_PLAIN) return n0;
    if (map == MAP_UP1) return 256 * (n0 >> 7) + (n0 & 127);
    if (map == MAP_UP3) return 256 * (n0 >> 7) + 128 + (n0 & 127);
    if (n0 < 1024 || n0 >= 3072) return n0;
    if (n0 < 2048) { const int cc = n0 - 1024; return 1024 + 256 * (cc >> 7) + (cc & 127); }
    { const int cc = n0 - 2048; return 1024 + 256 * (cc >> 7) + 128 + (cc & 127); }
}

struct Args { const float* in[28]; float* out; unsigned char* ws; int ph_lo, ph_hi; };

__device__ __forceinline__ void prologue(const Args& a, LAS unsigned char* lds, int tid, int lane, int wave, int bid, int G) {
    unsigned char* ws = a.ws;
    { float* rsz = (float*)(ws + WS_RS2); for (int i = bid * NTHR + tid; i < 2 * M; i += G * NTHR) rsz[i] = 0.f; }
    for (int job = bid; job < NMODC / 32; job += G) {
        const int n0 = job * 32, l31 = lane & 31, h5 = lane >> 5;
        f32x16 acc;
#pragma unroll
        for (int r = 0; r < 16; ++r) acc[r] = 0.f;
        const float* cp = a.in[1] + (size_t)l31 * D + wave * 128 + 8 * h5;
        const float* wp = a.in[2] + (size_t)(wave * 128 + 8 * h5) * NMODC + n0 + l31;
#pragma unroll
        for (int kk = 0; kk < 8; ++kk) {
            const f32x4 c0 = *(const f32x4*)(cp + 16 * kk), c1 = *(const f32x4*)(cp + 16 * kk + 4);
            float wv[8];
#pragma unroll
            for (int j = 0; j < 8; ++j) wv[j] = wp[(size_t)(16 * kk + j) * NMODC];
            u32x4 ua, ub;
            ua.x = pk2(c0.x / (1.0f + __expf(-c0.x)), c0.y / (1.0f + __expf(-c0.y))); ua.y = pk2(c0.z / (1.0f + __expf(-c0.z)), c0.w / (1.0f + __expf(-c0.w)));
            ua.z = pk2(c1.x / (1.0f + __expf(-c1.x)), c1.y / (1.0f + __expf(-c1.y))); ua.w = pk2(c1.z / (1.0f + __expf(-c1.z)), c1.w / (1.0f + __expf(-c1.w)));
            ub.x = pk2(wv[0], wv[1]); ub.y = pk2(wv[2], wv[3]); ub.z = pk2(wv[4], wv[5]); ub.w = pk2(wv[6], wv[7]);
            acc = __builtin_amdgcn_mfma_f32_32x32x16_bf16(__builtin_bit_cast(bf16x8, ua), __builtin_bit_cast(bf16x8, ub), acc, 0, 0, 0);
        }
        LAS float* part = (LAS float*)lds;
#pragma unroll
        for (int r = 0; r < 16; ++r) part[(wave * 32 + (r & 3) + 8 * (r >> 2) + 4 * h5) * 32 + l31] = acc[r];
        __syncthreads();
        float* mod = (float*)(ws + WS_MOD);
        for (int o = tid; o < 1024; o += NTHR) {
            const int b = o >> 5, n = o & 31; float sacc = a.in[3][n0 + n];
#pragma unroll
            for (int w8 = 0; w8 < 8; ++w8) sacc += part[(w8 * 32 + b) * 32 + n];
            mod[(size_t)b * NMODC + n0 + n] = sacc;
        }
        __syncthreads();
    }
    if (bid >= G - 4) {
        const int g = (bid - (G - 4)) * 8 + wave, p = lane;
        const float dt = expf(a.in[18][g]);
        const float ar = a.in[12][g * 64 + p], ai = a.in[13][g * 64 + p];
        const float e = expf(ar * dt); float sn, cs; sincosf(ai * dt, &sn, &cs);
        const float abr = e * cs, abi = e * sn;
        const float nr = abr - 1.0f, ni = abi, den = ar * ar + ai * ai;
        const float cr = (nr * ar + ni * ai) / den, ci = (ni * ar - nr * ai) / den;
        float* abar = (float*)(ws + WS_ABAR);
        abar[2 * (g * 64 + p)] = abr; abar[2 * (g * 64 + p) + 1] = abi;
        bf16* Bm = (bf16*)(ws + WS_BMAT);
        unsigned* Cm = (unsigned*)(ws + WS_CMAT);
        float re[16], im[16];
#pragma unroll
        for (int h = 0; h < 16; ++h) { const float br = a.in[14][(size_t)(g * 64 + p) * 16 + h], bi = a.in[15][(size_t)(g * 64 + p) * 16 + h]; re[h] = cr * br - ci * bi; im[h] = cr * bi + ci * br; }
        u32x4* d0 = (u32x4*)(Bm + (size_t)(g * 128 + 2 * p) * 16);
        { u32x4 w0, w1, w2, w3;
          w0.x = pk2(re[0], re[1]); w0.y = pk2(re[2], re[3]); w0.z = pk2(re[4], re[5]); w0.w = pk2(re[6], re[7]);
          w1.x = pk2(re[8], re[9]); w1.y = pk2(re[10], re[11]); w1.z = pk2(re[12], re[13]); w1.w = pk2(re[14], re[15]);
          w2.x = pk2(im[0], im[1]); w2.y = pk2(im[2], im[3]); w2.z = pk2(im[4], im[5]); w2.w = pk2(im[6], im[7]);
          w3.x = pk2(im[8], im[9]); w3.y = pk2(im[10], im[11]); w3.z = pk2(im[12], im[13]); w3.w = pk2(im[14], im[15]);
          d0[0] = w0; d0[1] = w1; d0[2] = w2; d0[3] = w3; }
#pragma unroll
        for (int h = 0; h < 16; ++h) Cm[(size_t)(g * 16 + h) * 64 + p] = pk2(a.in[16][(size_t)(g * 16 + h) * 64 + p], -a.in[17][(size_t)(g * 16 + h) * 64 + p]);
    }
    LAS float* scr = (LAS float*)(lds + wave * 16384);
    const int gw = bid * NWAVES + wave, NGW = G * NWAVES;
#define TRJ(idx, K_, N_, wsoff, MAP_) if (!found) { constexpr int items = ((K_) / 64) * ((N_) / 32); if (r < items) { found = true; W = a.in[idx]; K = (K_); N = (N_); WT = (bf16*)(ws + (wsoff)); map = (MAP_); } else r -= items; }
    constexpr int NITEMS = 2 * (3 * (D / 64) * (FF / 32)) + (D / 64) * (NIN / 32) + 2 * (D / 64) * (D / 32) + (SW / 64) * (SW / 32) + (SW / 64) * (D / 32);
#pragma unroll 1
    for (int it = gw; it < NITEMS; it += NGW) {
        int r = it; bool found = false; const float* W = nullptr; int K = 64, N = 32, map = 0; bf16* WT = nullptr;
        TRJ(5, D, FF, WS_WUPA, MAP_UP1)
        TRJ(6, D, FF, WS_WUPA, MAP_UP3)
        TRJ(7, FF, D, WS_WDNA, MAP_PLAIN)
        TRJ(9, D, NIN, WS_WIN, MAP_WIN)
        TRJ(11, D, D, WS_WC, MAP_PLAIN)
        TRJ(20, SW, SW, WS_WG, MAP_PLAIN)
        TRJ(21, SW, D, WS_WS, MAP_PLAIN)
        TRJ(22, D, D, WS_WO, MAP_PLAIN)
        TRJ(24, D, FF, WS_WUPB, MAP_UP1)
        TRJ(25, D, FF, WS_WUPB, MAP_UP3)
        TRJ(26, FF, D, WS_WDNB, MAP_PLAIN)
        const int nbn = N / 32, kb = r / nbn, nb = r % nbn;
        tr_item(W, K, N, 64 * kb, 32 * nb, WT, map_row(map, 32 * nb), scr, lane);
    }
#undef TRJ
}

__device__ __forceinline__ void tw_jobs(const float* mod, const bf16* Bt0, const bf16* Bt1, float* tw0, float* tw1, LAS unsigned char* lds, int tid, int lane, int wave, int bid, int G) {
    for (int job = bid; job < 2 * (NIN / 32); job += G) {
        const int which = job / (NIN / 32), n0 = (job % (NIN / 32)) * 32, l31 = lane & 31, h5 = lane >> 5;
        const float* tp = mod + (which == 0 ? 3 * D : 6 * D) + (size_t)l31 * NMODC + wave * 128 + 8 * h5;
        const bf16* bp = (which == 0 ? Bt0 : Bt1) + (size_t)(n0 + l31) * D + wave * 128 + 8 * h5;
        float* tw = which == 0 ? tw0 : tw1;
        f32x16 acc;
#pragma unroll
        for (int r = 0; r < 16; ++r) acc[r] = 0.f;
#pragma unroll
        for (int kk = 0; kk < 8; ++kk) {
            const f32x4 c0 = *(const f32x4*)(tp + 16 * kk), c1 = *(const f32x4*)(tp + 16 * kk + 4);
            u32x4 ua; ua.x = pk2(c0.x, c0.y); ua.y = pk2(c0.z, c0.w); ua.z = pk2(c1.x, c1.y); ua.w = pk2(c1.z, c1.w);
            const bf16x8 bfr = *(const bf16x8*)(bp + 16 * kk);
            acc = __builtin_amdgcn_mfma_f32_32x32x16_bf16(__builtin_bit_cast(bf16x8, ua), bfr, acc, 0, 0, 0);
        }
        LAS float* part = (LAS float*)lds;
#pragma unroll
        for (int r = 0; r < 16; ++r) part[(wave * 32 + (r & 3) + 8 * (r >> 2) + 4 * h5) * 32 + l31] = acc[r];
        __syncthreads();
        for (int o = tid; o < 1024; o += NTHR) {
            const int b = o >> 5, n = o & 31; float sacc = 0.f;
#pragma unroll
            for (int w8 = 0; w8 < 8; ++w8) sacc += part[(w8 * 32 + b) * 32 + n];
            tw[(size_t)b * NIN + n0 + n] = sacc;
        }
        __syncthreads();
    }
}

__device__ __forceinline__ void norm_phase(const float* X, const float* gvec, const float* modsh, const float* modsc, bf16* outb, float* outf, int gw, int NGW, int lane) {
    for (int r0 = gw * 32; r0 < M; r0 += NGW * 32) {
        const int b = r0 / SEQ;
        f32x4 scl[4], sft[4];
#pragma unroll
        for (int j = 0; j < 4; ++j) {
            const f32x4 gg = *(const f32x4*)(gvec + 4 * lane + 256 * j);
            if (modsh) { const f32x4 s1 = *(const f32x4*)(modsc + (size_t)b * NMODC + 4 * lane + 256 * j); scl[j] = gg * (s1 + 1.0f); sft[j] = *(const f32x4*)(modsh + (size_t)b * NMODC + 4 * lane + 256 * j); }
            else { scl[j] = gg; sft[j] = (f32x4){0.f, 0.f, 0.f, 0.f}; }
        }
#pragma unroll 1
        for (int rr = 0; rr < 32; rr += 4) {
            asm volatile("" ::: "memory");
            f32x4 v[4][4];
#pragma unroll
            for (int q = 0; q < 4; ++q)
#pragma unroll
                for (int j = 0; j < 4; ++j) v[q][j] = *(const f32x4*)(X + (size_t)(r0 + rr + q) * D + 4 * lane + 256 * j);
#pragma unroll
            for (int q = 0; q < 4; ++q) {
                float s = 0.f;
#pragma unroll
                for (int j = 0; j < 4; ++j) s += (v[q][j].x * v[q][j].x + v[q][j].y * v[q][j].y) + (v[q][j].z * v[q][j].z + v[q][j].w * v[q][j].w);
                s = wave_sum(s);
                const float rstd = 1.0f / sqrtf(s * (1.0f / D) + EPS);
                const size_t ro = (size_t)(r0 + rr + q) * D + 4 * lane;
#pragma unroll
                for (int j = 0; j < 4; ++j) {
                    const f32x4 o = v[q][j] * rstd * scl[j] + sft[j];
                    if (outb) { u32x2 w; w.x = pk2(o.x, o.y); w.y = pk2(o.z, o.w); *(u32x2*)(outb + ro + 256 * j) = w; }
                    else *(f32x4*)(outf + ro + 256 * j) = o;
                }
            }
        }
    }
}

__device__ __forceinline__ void ssm_chunk(const bf16x8 Af, int t0, LAS float* Bu, LAS unsigned* Xs, LAS unsigned char* Us, const bf16x8 (&Bf)[4], const bf16x8 (&Cf)[4],
                                          const f32x2 ab, const float dsk, float& xr, float& xi, bf16* Sb, int lane) {
    const int l31 = lane & 31, h5 = lane >> 5, l15 = lane & 15, q4 = lane >> 4;
    *(LAS bf16x8*)(Us + l31 * 32 + h5 * 16) = Af;
#pragma unroll
    for (int nb = 0; nb < 4; ++nb) {
        f32x16 c;
#pragma unroll
        for (int r = 0; r < 16; ++r) c[r] = 0.f;
        c = __builtin_amdgcn_mfma_f32_32x32x16_bf16(Af, Bf[nb], c, 0, 0, 0);
#pragma unroll
        for (int r = 0; r < 16; ++r) Bu[((r & 3) + 8 * (r >> 2) + 4 * h5) * 128 + 32 * nb + l31] = c[r];
    }
    LDS_WAIT();
    f32x2 bu[32];
#pragma unroll
    for (int t = 0; t < 32; ++t) bu[t] = *(const LAS f32x2*)(Bu + t * 128 + 2 * lane);
#pragma unroll
    for (int t = 0; t < 32; ++t) {
        const float nr = __builtin_fmaf(ab.x, xr, __builtin_fmaf(-ab.y, xi, bu[t].x));
        const float ni = __builtin_fmaf(ab.x, xi, __builtin_fmaf(ab.y, xr, bu[t].y));
        xr = nr; xi = ni;
        Xs[t * 68 + lane] = pk2(nr, ni);
    }
    LDS_WAIT();
    f32x4 y[2];
#pragma unroll
    for (int mb = 0; mb < 2; ++mb) {
        y[mb] = (f32x4){0.f, 0.f, 0.f, 0.f};
#pragma unroll
        for (int kb = 0; kb < 4; ++kb) {
            const bf16x8 xa = *(const LAS bf16x8*)((const LAS unsigned char*)Xs + (16 * mb + l15) * 272 + (32 * kb + 8 * q4) * 2);
            y[mb] = __builtin_amdgcn_mfma_f32_16x16x32_bf16(xa, Cf[kb], y[mb], 0, 0, 0);
        }
    }
#pragma unroll
    for (int mb = 0; mb < 2; ++mb)
#pragma unroll
        for (int r = 0; r < 4; ++r) {
            const int t = 16 * mb + 4 * q4 + r;
            const float u = bf2f(*(const LAS bf16*)(Us + t * 32 + l15 * 2));
            const float sv = y[mb][r] + dsk * u;
            Sb[(size_t)(t0 + t) * SW + l15] = (bf16)(pk2(fgelu_tanh(sv), 0.f) & 0xffffu);
        }
    LDS_WAIT();
}
__device__ __forceinline__ void ssm_job(int job, LAS unsigned char* wl, const bf16* U, bf16* S, const float* abar, const bf16* Bmat, const bf16* CmT, const float* dskip, int lane) {
    const int b = job >> 5, g = job & 31;
    const int l31 = lane & 31, h5 = lane >> 5, l15 = lane & 15, q4 = lane >> 4;
    bf16x8 Bf[4], Cf[4];
#pragma unroll
    for (int nb = 0; nb < 4; ++nb) Bf[nb] = *(const bf16x8*)(Bmat + ((size_t)(g * 128 + 32 * nb + l31) * 16 + 8 * h5));
#pragma unroll
    for (int kb = 0; kb < 4; ++kb) Cf[kb] = *(const bf16x8*)(CmT + ((size_t)(g * 16 + l15) * 128 + 32 * kb + 8 * q4));
    const f32x2 ab = *(const f32x2*)(abar + 2 * (g * 64 + lane));
    const float dsk = dskip[16 * g + l15];
    float xr = 0.f, xi = 0.f;
    LAS float* Bu = (LAS float*)wl;
    LAS unsigned* Xs = (LAS unsigned*)(wl + 16384);
    LAS unsigned char* Us = wl + 16384 + 8704;
    const bf16* Ub = U + (size_t)b * SEQ * SW + 16 * g + (size_t)l31 * SW + 8 * h5;
    bf16* Sb = S + (size_t)b * SEQ * SW + 16 * g;
    bf16x8 nxt[4];
#pragma unroll
    for (int c = 0; c < 4; ++c) nxt[c] = *(const bf16x8*)(Ub + (size_t)(32 * c) * SW);
#pragma unroll 1
    for (int grp = 0; grp < SEQ / 128; ++grp) {
        const int t0 = grp * 128;
        bf16x8 cur[4];
#pragma unroll
        for (int c = 0; c < 4; ++c) cur[c] = nxt[c];
        ssm_chunk(cur[0], t0, Bu, Xs, Us, Bf, Cf, ab, dsk, xr, xi, Sb, lane);
        if (grp + 1 < SEQ / 128) {
#pragma unroll
            for (int c = 0; c < 4; ++c) nxt[c] = *(const bf16x8*)(Ub + (size_t)(t0 + 128 + 32 * c) * SW);
        }
        ssm_chunk(cur[1], t0 + 32, Bu, Xs, Us, Bf, Cf, ab, dsk, xr, xi, Sb, lane);
        ssm_chunk(cur[2], t0 + 64, Bu, Xs, Us, Bf, Cf, ab, dsk, xr, xi, Sb, lane);
        ssm_chunk(cur[3], t0 + 96, Bu, Xs, Us, Bf, Cf, ab, dsk, xr, xi, Sb, lane);
    }
}

__device__ __forceinline__ void conv_job(int j, const bf16* Z, const bf16* GB, bf16* YA, const float* cwt, int lane) {
    const int b = j >> 7, rem = j & 127, tb = rem >> 1, half = rem & 1;
    const int col = half * 512 + lane * 8;
    float w0[8], w1[8], w2[8];
#pragma unroll
    for (int i = 0; i < 8; ++i) { w0[i] = cwt[col + i]; w1[i] = cwt[D + col + i]; w2[i] = cwt[2 * D + col + i]; }
    const size_t rowbase = (size_t)b * SEQ + tb * 32;
    float z2[8], z1[8];
#pragma unroll
    for (int i = 0; i < 8; ++i) { z2[i] = 0.f; z1[i] = 0.f; }
    if (tb > 0) { unpack8(*(const u32x4*)(Z + (rowbase - 2) * D + col), z2); unpack8(*(const u32x4*)(Z + (rowbase - 1) * D + col), z1); }
#pragma unroll 1
    for (int t = 0; t < 32; t += 8) {
        u32x4 zr[8], gr[8];
#pragma unroll
        for (int q = 0; q < 8; ++q) { zr[q] = *(const u32x4*)(Z + (rowbase + t + q) * D + col); gr[q] = *(const u32x4*)(GB + (rowbase + t + q) * D + col); }
#pragma unroll
        for (int q = 0; q < 8; ++q) {
            float zc[8], gb[8], o[8];
            unpack8(zr[q], zc); unpack8(gr[q], gb);
#pragma unroll
            for (int i = 0; i < 8; ++i) { o[i] = gb[i] * (w0[i] * z2[i] + w1[i] * z1[i] + w2[i] * zc[i]); z2[i] = z1[i]; z1[i] = zc[i]; }
            *(u32x4*)(YA + (rowbase + t + q) * D + col) = pack8(o);
        }
        asm volatile("" ::: "memory");
    }
}

#ifndef REPEAT_PH
#define REPEAT_PH -1
#endif
#ifndef PROBE_A
#define PROBE_A -1
#define PROBE_B -1
#endif
constexpr int NPH = 15;
__global__ void __launch_bounds__(NTHR, 2) fwd_kernel(Args a) {
    extern __shared__ __attribute__((aligned(16))) unsigned char lds_raw[];
    LAS unsigned char* lds = (LAS unsigned char*)lds_raw;
    const int tid0 = threadIdx.x;
    const int G = gridDim.x, bid0 = blockIdx.x;
    unsigned char* ws0 = a.ws;
    volatile LAS unsigned* MISC = (volatile LAS unsigned*)(lds + 131072 + 320);
    if (tid0 < 32) MISC[tid0] = 0u;
    __syncthreads();
    const XcdBarrier xbar = xcd_barrier_post((unsigned*)(ws0 + WS_BAR), MISC + 8);

    bool repeated = false; (void)repeated;
#pragma unroll 1
    for (int ph = a.ph_lo; ph < a.ph_hi; ++ph) {
        int tid = tid0, bid = bid0; __attribute__((address_space(1))) unsigned char* wsg = (__attribute__((address_space(1))) unsigned char*)ws0;
        asm volatile("" : "+v"(tid)); asm volatile("" : "+s"(bid)); asm volatile("" : "+s"(wsg));
        unsigned char* ws = (unsigned char*)wsg;
        const int lane = tid & 63, wave = __builtin_amdgcn_readfirstlane(tid >> 6);
        const int gw = bid * NWAVES + wave, NGW = G * NWAVES;
        float* mod = (float*)(ws + WS_MOD);
        float* X1 = (float*)(ws + WS_X1);
        float* X2 = a.out;
        bf16* XN = (bf16*)(ws + WS_XN); bf16* HB = (bf16*)(ws + WS_HB);
        bf16* Zb = (bf16*)a.out; bf16* GBb = (bf16*)a.out + (size_t)M * D;
        bf16* Ub = (bf16*)(ws + WS_U); bf16* SAb = (bf16*)(ws + WS_SA); bf16* SBb = (bf16*)(ws + WS_SB);
        bf16* Sb = (bf16*)(ws + WS_S); bf16* S2b = (bf16*)(ws + WS_S2); bf16* YAb = (bf16*)(ws + WS_YA);
#if PROBE_A >= 0
        if (bid == 0 && tid == 0) ((unsigned long long*)(ws + 65536))[ph] = __builtin_amdgcn_s_memrealtime();
#endif
        bool is_gemm = false, sync_after = true;
        pg8::Gemm g{nullptr, nullptr, M, 0, 0};
        Epi E{}; E.ws = ws; E.dout = a.out; E.xin = a.in[0];
        switch (ph) {
        case 0: prologue(a, lds, tid, lane, wave, bid, G); break;
        case 1: tw_jobs(mod, (const bf16*)(ws + WS_WIN), (const bf16*)(ws + WS_WUPB), (float*)(ws + WS_TW2), (float*)(ws + WS_TW3), lds, tid, lane, wave, bid, G);
                norm_phase(a.in[0], a.in[4], mod + 0 * D, mod + 1 * D, XN, nullptr, gw, NGW, lane); break;
        case 2: is_gemm = true; g.A = XN; g.Bt = (const bf16*)(ws + WS_WUPA); g.N = NUP; g.K = D; E.mode = EM_SWIGLU; E.variant = 0; break;
        case 3: is_gemm = true; g.A = HB; g.Bt = (const bf16*)(ws + WS_WDNA); g.N = D; g.K = FF; E.mode = EM_RES; E.variant = 0; E.gvec = a.in[8]; break;
        case 4: sync_after = false; break;
        case 5: is_gemm = true; g.A = XN; g.Bt = (const bf16*)(ws + WS_WIN); g.N = NIN; g.K = D; E.mode = EM_WIN; break;
        case 6: {
            if (wave < 4) {
#if defined(PROBE_SKIP_SSM)
                if (repeated)
#endif
                for (int job = bid * 4 + wave; job < BATCH * 32; job += G * 4)
                    ssm_job(job, lds + wave * 32768, Ub, Sb, (const float*)(ws + WS_ABAR), (const bf16*)(ws + WS_BMAT), (const bf16*)(ws + WS_CMAT), a.in[19], lane);
            } else {
                for (int j = bid * 4 + (wave - 4); j < BATCH * 128; j += G * 4) conv_job(j, Zb, GBb, YAb, a.in[10], lane);
            }
        } break;
        case 7: is_gemm = true; sync_after = false; g.A = YAb; g.Bt = (const bf16*)(ws + WS_WC); g.N = D; g.K = D; E.mode = EM_MULA; break;
        case 8: is_gemm = true; g.A = Sb; g.Bt = (const bf16*)(ws + WS_WG); g.N = SW; g.K = SW; E.mode = EM_GLU; break;
        case 9: is_gemm = true; g.A = S2b; g.Bt = (const bf16*)(ws + WS_WS); g.N = D; g.K = SW; E.mode = EM_MERGE; break;
        case 10: is_gemm = true; g.A = SAb; g.Bt = (const bf16*)(ws + WS_WO); g.N = D; g.K = D; E.mode = EM_RES; E.variant = 1; E.gvec = a.in[23]; break;
        case 11: sync_after = false; break;
        case 12: is_gemm = true; g.A = XN; g.Bt = (const bf16*)(ws + WS_WUPB); g.N = NUP; g.K = D; E.mode = EM_SWIGLU; E.variant = 1; break;
        case 13: is_gemm = true; g.A = HB; g.Bt = (const bf16*)(ws + WS_WDNB); g.N = D; g.K = FF; E.mode = EM_RES; E.variant = 2; break;
        case 14: norm_phase(X1, a.in[27], nullptr, nullptr, nullptr, a.out, gw, NGW, lane); break;
#if PROBE_A >= 0
        case 15: {
            const unsigned long long* ts = (const unsigned long long*)(ws + 65536);
            const float e1 = (float)(ts[PROBE_A + 1] - ts[PROBE_A]) * 1e-4f, e2 = (float)(ts[PROBE_B + 1] - ts[PROBE_B]) * 1e-5f;
            for (size_t i = (size_t)bid * NTHR + tid; i < (size_t)(1u << 22); i += (size_t)G * NTHR) a.out[i] += e2;
            if (bid == 0 && tid == 0) a.out[(1u << 22) + 5] += e1;
        } break;
#endif
        default: break;
        }
        if (is_gemm) {
#if REPEAT_PH >= 0
            if (ph == REPEAT_PH && !repeated) E.mode = -1;
#endif
            pg8::StaticOrder S; S.init(g.M, g.N, G, bid);
            pg8::gemm_phase<Epi, pg8::StaticOrder, true, true>(lds, g, S, E);
        }
        if (ph + 1 < a.ph_hi && sync_after) { if (ph == 0) cg::this_grid().sync(); else xcd_barrier(xbar); }
#if REPEAT_PH >= 0
        if (ph == REPEAT_PH && !repeated) { repeated = true; if (!sync_after || ph + 1 >= a.ph_hi) cg::this_grid().sync(); --ph; }
#endif
    }
}

#ifndef MK_MULTI
#define MK_MULTI 0
#endif
extern "C" void kernel_launch(void* const* d_in, const int* in_sizes, int n_in, void* d_out, int out_size, void* d_ws, size_t ws_size, hipStream_t stream) {
    static int grid = 0;
    if (grid == 0) {
        if (n_in != 28 || in_sizes[0] != M * D || out_size != M * D || ws_size < WS_END) { fprintf(stderr, "kernel_launch: unexpected shapes (n_in %d, in0 %d, out %d, ws %zu)\n", n_in, n_in > 0 ? in_sizes[0] : -1, out_size, ws_size); grid = -1; return; }
        int dev = 0, cus = 0, per_cu = 0;
        if (hipGetDevice(&dev) != hipSuccess || hipDeviceGetAttribute(&cus, hipDeviceAttributeMultiprocessorCount, dev) != hipSuccess) { grid = -1; return; }
        if (hipFuncSetAttribute((const void*)fwd_kernel, hipFuncAttributeMaxDynamicSharedMemorySize, LDS_BYTES) != hipSuccess) { fprintf(stderr, "kernel_launch: hipFuncSetAttribute failed\n"); grid = -1; return; }
        if (hipOccupancyMaxActiveBlocksPerMultiprocessor(&per_cu, (const void*)fwd_kernel, NTHR, LDS_BYTES) != hipSuccess || per_cu < 1) { fprintf(stderr, "kernel_launch: occupancy query says %d\n", per_cu); per_cu = 1; }
        (void)hipGetLastError();
        grid = cus * per_cu;
        fprintf(stderr, "kernel_launch: grid %d (cus %d x %d)\n", grid, cus, per_cu);
    }
    if (grid < 0) return;
    if (hipMemsetAsync((char*)d_ws + WS_BAR, 0, WS_BAR_BYTES, stream) != hipSuccess) { fprintf(stderr, "kernel_launch: memset failed\n"); return; }
    Args a{};
    for (int i = 0; i < 28; ++i) a.in[i] = (const float*)d_in[i];
    a.out = (float*)d_out; a.ws = (unsigned char*)d_ws;
#if MK_MULTI
    for (int ph = 0; ph < NPH; ++ph) { a.ph_lo = ph; a.ph_hi = ph + 1; hipLaunchKernelGGL(fwd_kernel, dim3(grid), dim3(NTHR), LDS_BYTES, stream, a); }
#else
    a.ph_lo = 0; a.ph_hi = NPH + (PROBE_A >= 0 ? 1 : 0);
    void* kargs[] = {(void*)&a};
    hipError_t e = hipLaunchCooperativeKernel((const void*)fwd_kernel, dim3(grid), dim3(NTHR), kargs, LDS_BYTES, stream);
    if (e != hipSuccess) fprintf(stderr, "kernel_launch: cooperative launch failed: %s (grid %d)\n", hipGetErrorString(e), grid);
#endif
}
```

```cpp
#include <hip/hip_runtime.h>
#include <hip/hip_cooperative_groups.h>
#include <cstdio>
#include <cstdint>
namespace cg = cooperative_groups;
namespace pg8 {
#define PG8_LAS __attribute__((address_space(3)))
typedef unsigned short bf16_t;
typedef short bf16x8 __attribute__((ext_vector_type(8)));
typedef float f32x4 __attribute__((ext_vector_type(4)));
typedef unsigned u32x4 __attribute__((ext_vector_type(4)));
constexpr int BM = 256, BK = 64, HALF = 128, HTB = HALF * BK * 2  , STAGE_BYTES = 8 * HTB, NXCD = 8, WGM = 8;

__host__ __device__ __forceinline__ int lds_byte(int r, int c) { const int st = (r >> 4) * 2 + (c >> 5), rr = r & 15, cc = c & 31, ob = rr * 64 + cc * 2; return st * 1024 + (ob ^ (((ob >> 9) & 1) << 5)); }
__host__ __device__ __forceinline__ void stage_rc(int b, int& R, int& C) { const int st = b / 1024, sb = b % 1024, swz = sb ^ (((sb >> 9) & 1) << 5); R = (st >> 1) * 16 + swz / 64; C = (st & 1) * 32 + (swz % 64) / 2; }
__host__ __device__ __forceinline__ int perm32(int rho) { const int n = rho >> 4, i = rho & 15; return 8 * (i >> 2) + 4 * n + (i & 3); }

struct Unit { int pm, pn; };
struct Gemm { const bf16_t* A; const bf16_t* Bt; int M, N, K; };

struct StaticOrder {
    int nM, nN, nwg, G, c;
    __host__ __device__ void init(int M, int N, int G_, int c_) { nM = M / BM; nN = N / BM; nwg = nM * nN; G = G_; c = c_; }
    __host__ __device__ bool next(int i, Unit& u) const {
        const long L = (long)i * G + c; if (L >= nwg) return false;
        int wgid = (int)L; { const int q = nwg / NXCD, r = nwg % NXCD, xcd = wgid % NXCD, off = wgid / NXCD; wgid = (xcd < r ? xcd * (q + 1) : r * (q + 1) + (xcd - r) * q) + off; }
        const int nig = WGM * nN, gid = wgid / nig, fm = gid * WGM, gsz = (nM - fm) < WGM ? (nM - fm) : WGM;
        u.pm = fm + ((wgid % nig) % gsz); u.pn = (wgid % nig) / gsz; return true;
    }
    __device__ __forceinline__ void a_ready(const Unit&) const {}
    __device__ __forceinline__ void done(const Unit&) const {}
};

__device__ __forceinline__ unsigned cvt_pk_bf16(float lo, float hi) { unsigned r; asm volatile("v_cvt_pk_bf16_f32 %0, %1, %2" : "=v"(r) : "v"(lo), "v"(hi)); return r; }
template <class Epi, class Sched, bool ALIGN_EPI = false, bool SP2 = false>
__device__ __forceinline__ void gemm_phase(PG8_LAS unsigned char* lds, const Gemm g, const Sched& S, const Epi& E) {
    const int tid = threadIdx.x, wid = __builtin_amdgcn_readfirstlane(tid >> 6), lane = tid & 63, wr = wid >> 2, wc = wid & 3, fr = lane & 15, fq = lane >> 4;
    const int K = g.K, nt = K / BK;
    unsigned voffA[2], voffB[2];
#pragma unroll
    for (int i = 0; i < 2; ++i) { int R, C; stage_rc(tid * 16 + i * 8192, R, C); const int Rb = Epi::PERM ? ((R & ~31) + perm32(R & 31)) : R;
        voffA[i] = (unsigned)(R * K + C) * 2u; voffB[i] = (unsigned)(Rb * K + C) * 2u; }
    const size_t kstep = (size_t)(BK * 2);
    const size_t hstep = (size_t)HALF * K * 2;
    const size_t tstep = 2 * hstep;
    const unsigned ldsw = (unsigned)wid * 1024u;
    const int aoff = lds_byte(wr * 64 + fr, fq * 8), boff = lds_byte(wc * 32 + fr, fq * 8);
#define PG8_SA(b, h) (((b) * 2 + (h)) * HTB)
#define PG8_SB(b, h) ((4 + (b) * 2 + (h)) * HTB)
#define PG8_STAGE(bufoff, gbase, voff) do { _Pragma("unroll") for (int _i = 0; _i < 2; ++_i) \
        __builtin_amdgcn_global_load_lds((const unsigned*)((const char*)(gbase) + (voff)[_i]), (PG8_LAS unsigned*)(lds + (bufoff) + ldsw + _i * 8192), 16, 0, 0); } while (0)
#define PG8_LDA(dst, b, h) do { _Pragma("unroll") for (int m = 0; m < 4; ++m) _Pragma("unroll") for (int k = 0; k < 2; ++k) dst[m][k] = *(const PG8_LAS bf16x8*)(lds + PG8_SA(b, h) + aoff + m * 2048 + k * 1024); } while (0)
#define PG8_LDB(dst, b, h) do { _Pragma("unroll") for (int n = 0; n < 2; ++n) _Pragma("unroll") for (int k = 0; k < 2; ++k) dst[n][k] = *(const PG8_LAS bf16x8*)(lds + PG8_SB(b, h) + boff + n * 2048 + k * 1024); } while (0)
#define PG8_MMA(ai, bj, At, Bt) do { __builtin_amdgcn_s_setprio(1); _Pragma("unroll") for (int m = 0; m < 4; ++m) _Pragma("unroll") for (int n = 0; n < 2; ++n) _Pragma("unroll") for (int k = 0; k < 2; ++k) \
        acc[ai][bj][m][n] = __builtin_amdgcn_mfma_f32_16x16x32_bf16(Bt[n][k], At[m][k], acc[ai][bj][m][n], 0, 0, 0); __builtin_amdgcn_s_setprio(0); } while (0)
#define PG8_WAIT_V(n) asm volatile("s_waitcnt vmcnt(" #n ")" ::: "memory")
#define PG8_WAIT_L(n) asm volatile("s_waitcnt lgkmcnt(" #n ")" ::: "memory")
#define PG8_BAR __builtin_amdgcn_s_barrier()
#define PG8_SCHED __builtin_amdgcn_sched_barrier(0)
    Unit cur, nxt; int ui = 0;
    if (!S.next(0, cur)) return;
    f32x4 acc[2][2][4][2];
#pragma unroll
    for (int a = 0; a < 2; ++a)
#pragma unroll
        for (int b = 0; b < 2; ++b)
#pragma unroll
            for (int m = 0; m < 4; ++m)
#pragma unroll
                for (int n = 0; n < 2; ++n) acc[a][b][m][n] = (f32x4){0.f, 0.f, 0.f, 0.f};
    bf16x8 At[4][2], B0[2][2], B1[2][2];
    const char* cA = (const char*)g.A + (size_t)cur.pm * tstep; const char* cB = (const char*)g.Bt + (size_t)cur.pn * tstep;
    S.a_ready(cur);
    if constexpr (SP2) {
        PG8_STAGE(PG8_SB(0, 0), cB, voffB); PG8_STAGE(PG8_SB(0, 1), cB + hstep, voffB); PG8_STAGE(PG8_SA(0, 0), cA, voffA); PG8_STAGE(PG8_SA(0, 1), cA + hstep, voffA);
        if (wr == 1) PG8_BAR;
        PG8_WAIT_V(2); PG8_BAR;
        PG8_STAGE(PG8_SB(1, 0), cB + kstep, voffB); PG8_STAGE(PG8_SA(1, 0), cA + kstep, voffA); PG8_STAGE(PG8_SB(1, 1), cB + hstep + kstep, voffB);
        PG8_WAIT_V(6); PG8_BAR;
    } else {
        PG8_STAGE(PG8_SB(0, 0), cB, voffB); PG8_STAGE(PG8_SA(0, 0), cA, voffA); PG8_STAGE(PG8_SB(0, 1), cB + hstep, voffB); PG8_STAGE(PG8_SA(0, 1), cA + hstep, voffA);
        if (wr == 1) PG8_BAR;
        PG8_WAIT_V(4); PG8_BAR;
        PG8_STAGE(PG8_SB(1, 0), cB + kstep, voffB); PG8_STAGE(PG8_SA(1, 0), cA + kstep, voffA); PG8_STAGE(PG8_SB(1, 1), cB + hstep + kstep, voffB);
        PG8_WAIT_V(6); PG8_BAR;
    }
    for (;;) {
        const bool has_next = S.next(ui + 1, nxt);
        const char* nA = has_next ? (const char*)g.A + (size_t)nxt.pm * tstep : cA; const char* nB = has_next ? (const char*)g.Bt + (size_t)nxt.pn * tstep : cB;
        for (int t = 0; t < nt; t += 2) {
            const bool last = (t == nt - 2);
            const char* a1 = cA + (size_t)(t + 1) * kstep;
            const char* a2 = last ? nA : cA + (size_t)(t + 2) * kstep; const char* b2 = last ? nB : cB + (size_t)(t + 2) * kstep;
            const char* a3 = a2 + kstep; const char* b3 = b2 + kstep;
            if (last && has_next) S.a_ready(nxt);
            if constexpr (SP2) {
            PG8_LDB(B0, 0, 0); PG8_LDB(B1, 0, 1); PG8_SCHED; PG8_LDA(At, 0, 0); PG8_STAGE(PG8_SA(1, 1), a1 + hstep, voffA);
            PG8_WAIT_V(8); PG8_WAIT_L(0); PG8_BAR; PG8_MMA(0, 0, At, B0); PG8_MMA(0, 1, At, B1); PG8_BAR; PG8_SCHED;
            PG8_LDA(At, 0, 1); PG8_STAGE(PG8_SB(0, 0), b2, voffB); PG8_STAGE(PG8_SB(0, 1), b2 + hstep, voffB); PG8_STAGE(PG8_SA(0, 0), a2, voffA);
            PG8_WAIT_V(8); PG8_WAIT_L(0); PG8_BAR; PG8_MMA(1, 0, At, B0); PG8_MMA(1, 1, At, B1); PG8_BAR; PG8_SCHED;
            PG8_LDB(B0, 1, 0); PG8_LDB(B1, 1, 1); PG8_SCHED; PG8_LDA(At, 1, 0); PG8_STAGE(PG8_SA(0, 1), a2 + hstep, voffA);
            PG8_WAIT_V(8); PG8_WAIT_L(0); PG8_BAR; PG8_MMA(0, 0, At, B0); PG8_MMA(0, 1, At, B1); PG8_BAR; PG8_SCHED;
            PG8_LDA(At, 1, 1); PG8_STAGE(PG8_SB(1, 0), b3, voffB); PG8_STAGE(PG8_SB(1, 1), b3 + hstep, voffB); PG8_STAGE(PG8_SA(1, 0), a3, voffA);
            PG8_WAIT_V(8); PG8_WAIT_L(0); PG8_BAR; PG8_MMA(1, 0, At, B0); PG8_MMA(1, 1, At, B1); PG8_BAR; PG8_SCHED;
            } else {
            PG8_LDB(B0, 0, 0); PG8_SCHED; PG8_LDA(At, 0, 0); PG8_STAGE(PG8_SA(1, 1), a1 + hstep, voffA);
            PG8_WAIT_L(8); PG8_BAR; PG8_WAIT_L(0); PG8_MMA(0, 0, At, B0); PG8_BAR; PG8_SCHED;
            PG8_LDB(B1, 0, 1); PG8_STAGE(PG8_SB(0, 0), b2, voffB);
            PG8_BAR; PG8_WAIT_L(0); PG8_MMA(0, 1, At, B1); PG8_BAR;
            PG8_LDA(At, 0, 1); PG8_STAGE(PG8_SA(0, 0), a2, voffA);
            PG8_BAR; PG8_WAIT_L(0); PG8_MMA(1, 0, At, B0); PG8_BAR; PG8_SCHED;
            PG8_STAGE(PG8_SB(0, 1), b2 + hstep, voffB);
            PG8_WAIT_V(6); PG8_BAR; PG8_MMA(1, 1, At, B1); PG8_BAR;
            PG8_LDB(B0, 1, 0); PG8_SCHED; PG8_LDA(At, 1, 0); PG8_STAGE(PG8_SA(0, 1), a2 + hstep, voffA);
            PG8_WAIT_L(8); PG8_BAR; PG8_WAIT_L(0); PG8_MMA(0, 0, At, B0); PG8_BAR; PG8_SCHED;
            PG8_LDB(B1, 1, 1); PG8_STAGE(PG8_SB(1, 0), b3, voffB);
            PG8_BAR; PG8_WAIT_L(0); PG8_MMA(0, 1, At, B1); PG8_BAR;
            PG8_LDA(At, 1, 1); PG8_STAGE(PG8_SA(1, 0), a3, voffA);
            PG8_BAR; PG8_WAIT_L(0); PG8_MMA(1, 0, At, B0); PG8_BAR; PG8_SCHED;
            PG8_STAGE(PG8_SB(1, 1), b3 + hstep, voffB);
            PG8_WAIT_V(6); PG8_BAR; PG8_MMA(1, 1, At, B1); PG8_BAR;
            }
        }
        if constexpr (ALIGN_EPI) { if (wr == 0) PG8_BAR; }
        if constexpr (!Epi::AFTER_DRAIN) { E(acc, cur, wr, wc, fr, fq); S.done(cur); }
        if (!has_next) break;
#pragma unroll
        for (int a = 0; a < 2; ++a)
#pragma unroll
            for (int b = 0; b < 2; ++b)
#pragma unroll
                for (int m = 0; m < 4; ++m)
#pragma unroll
                    for (int n = 0; n < 2; ++n) acc[a][b][m][n] = (f32x4){0.f, 0.f, 0.f, 0.f};
        cur = nxt; cA = nA; cB = nB; ++ui;
        if constexpr (ALIGN_EPI) { if (wr == 1) PG8_BAR; }
    }
    PG8_WAIT_V(0);
    if constexpr (!ALIGN_EPI) { if (wr == 0) PG8_BAR; }
    PG8_BAR;
    if constexpr (Epi::AFTER_DRAIN) { E.fused(acc, cur, wr, wc, fr, fq, lds, wid, lane); S.done(cur); }
#undef PG8_SA
#undef PG8_SB
#undef PG8_STAGE
#undef PG8_LDA
#undef PG8_LDB
#undef PG8_MMA
#undef PG8_WAIT_V
#undef PG8_WAIT_L
#undef PG8_BAR
#undef PG8_SCHED
}
}

constexpr int BATCH = 32, SEQ = 2048, D = 1024, M = BATCH * SEQ, FF = 2816, NUP = 2 * FF, NIN = 5632;
constexpr int SW = 512, NMODC = 9 * D;
constexpr float EPS = 1e-6f;
constexpr int NWAVES = 8, NTHR = 512;
constexpr int LDS_BYTES = 147456;
constexpr size_t MiB = 1u << 20;
constexpr size_t WS_BAR = 0, WS_BAR_BYTES = 16384;
constexpr size_t WS_MOD = 1 * MiB, WS_ABAR = 3 * MiB, WS_BMAT = 3 * MiB + 64 * 1024, WS_CMAT = 3 * MiB + 256 * 1024;
constexpr size_t WS_WUPA = 4 * MiB, WS_WDNA = 15 * MiB, WS_WIN = 21 * MiB, WS_WC = 32 * MiB, WS_WG = 34 * MiB, WS_WS = 35 * MiB, WS_WO = 36 * MiB, WS_WUPB = 38 * MiB, WS_WDNB = 49 * MiB;
constexpr size_t WS_X1 = 56 * MiB, WS_XN = 312 * MiB, WS_S = 312 * MiB, WS_S2 = 376 * MiB, WS_HB = 440 * MiB, WS_U = 440 * MiB, WS_SA = 504 * MiB, WS_SB = 632 * MiB, WS_YA = 792 * MiB, WS_TW2 = 920 * MiB, WS_TW3 = 921 * MiB, WS_END = 922 * MiB;
constexpr size_t WS_RS2 = 2 * MiB + 256 * 1024, WS_RS3 = 2 * MiB + 512 * 1024;

#define LAS __attribute__((address_space(3)))
typedef unsigned short bf16;
typedef unsigned u32x4 __attribute__((ext_vector_type(4)));
typedef unsigned u32x2 __attribute__((ext_vector_type(2)));
typedef float f32x4 __attribute__((ext_vector_type(4)));
typedef float f32x2 __attribute__((ext_vector_type(2)));
typedef float f32x16 __attribute__((ext_vector_type(16)));
typedef short bf16x8 __attribute__((ext_vector_type(8)));
#define LDS_WAIT() asm volatile("s_waitcnt lgkmcnt(0)" ::: "memory")

__device__ __forceinline__ unsigned pk2(float lo, float hi) { return pg8::cvt_pk_bf16(lo, hi); }
__device__ __forceinline__ float bflo(unsigned w) { return __uint_as_float(w << 16); }
__device__ __forceinline__ float bfhi(unsigned w) { return __uint_as_float(w & 0xffff0000u); }
__device__ __forceinline__ float bf2f(bf16 v) { return __uint_as_float((unsigned)v << 16); }
__device__ __forceinline__ float fsigmoid(float x) { return __builtin_amdgcn_rcpf(1.0f + __builtin_amdgcn_exp2f(-1.44269504f * x)); }
__device__ __forceinline__ float fsilu(float x) { return x * fsigmoid(x); }
__device__ __forceinline__ float fgelu_tanh(float x) { const float u = x + 0.044715f * x * x * x; return x * __builtin_amdgcn_rcpf(1.0f + __builtin_amdgcn_exp2f(-2.0f * 0.7978845608f * 1.44269504f * u)); }
__device__ __forceinline__ void unpack8(const u32x4 w, float (&f)[8]) { f[0] = bflo(w.x); f[1] = bfhi(w.x); f[2] = bflo(w.y); f[3] = bfhi(w.y); f[4] = bflo(w.z); f[5] = bfhi(w.z); f[6] = bflo(w.w); f[7] = bfhi(w.w); }
__device__ __forceinline__ u32x4 pack8(const float (&f)[8]) { u32x4 w; w.x = pk2(f[0], f[1]); w.y = pk2(f[2], f[3]); w.z = pk2(f[4], f[5]); w.w = pk2(f[6], f[7]); return w; }
__device__ __forceinline__ float wave_sum(float v) {
#pragma unroll
    for (int o = 1; o < 64; o <<= 1) v += __shfl_xor(v, o);
    return v;
}

#define XB_TMO      128
#define XB_XCNT(j)  (256  + 64 * (j))
#define XB_XSUB(j)  (1280 + 64 * (j))
#define XB_XGEN(j)  (2304 + 64 * (j))
#define XB_TOP      3328
#define XB_TOPGEN   3392
#define XCD_BAR_WORDS 3456
#define XB_SPIN_CAP (1u << 18)

__device__ __forceinline__ unsigned xb_ld(unsigned* p)              { return __hip_atomic_load(p, __ATOMIC_RELAXED, __HIP_MEMORY_SCOPE_AGENT); }
__device__ __forceinline__ unsigned xb_add(unsigned* p, unsigned v) { return __hip_atomic_fetch_add(p, v, __ATOMIC_RELAXED, __HIP_MEMORY_SCOPE_AGENT); }
__device__ __forceinline__ unsigned xb_xcc_id() { return (unsigned)__builtin_amdgcn_s_getreg((3 << 11) | 20) & 0xFu; }
#define XB_SPIN(cond, bar) do { unsigned _sp = 0; while (cond) { __builtin_amdgcn_s_sleep(1); \
    if ((++_sp & 255u) == 0u) { if (xb_ld(&(bar)[XB_TMO])) break; if (_sp > XB_SPIN_CAP) { atomicAdd(&(bar)[XB_TMO], 1u); break; } } } } while (0)

struct XcdBarrier {
    unsigned* bar; unsigned x;
    volatile LAS unsigned* st;
};

__device__ __forceinline__ XcdBarrier xcd_barrier_post(unsigned* bar, volatile LAS unsigned* st) {
    XcdBarrier b; b.bar = bar; b.x = xb_xcc_id(); b.st = st;
    if (threadIdx.x == 0) (void)xb_add(&bar[XB_XCNT(b.x)], 1u);
    return b;
}
__device__ __forceinline__ void xcd_barrier_complete(unsigned* bar, unsigned x, unsigned& nloc, unsigned& nx) {
    const unsigned G = gridDim.x * gridDim.y * gridDim.z;
    unsigned sum, cnt, mine, sp = 0u;
    for (;;) {
        sum = 0u; cnt = 0u; mine = 0u;
#pragma unroll
        for (unsigned j = 0; j < 16; ++j) { const unsigned c = xb_ld(&bar[XB_XCNT(j)]); sum += c; cnt += (c > 0u) ? 1u : 0u; mine = (j == x) ? c : mine; }
        if (sum == G) break;
        __builtin_amdgcn_s_sleep(1);
        if ((++sp & 255u) == 0u) { if (xb_ld(&bar[XB_TMO])) break; if (sp > XB_SPIN_CAP) { atomicAdd(&bar[XB_TMO], 1u); break; } }
    }
    nloc = mine > 0u ? mine : 1u; nx = cnt > 0u ? cnt : 1u;
}

__device__ __forceinline__ void xcd_barrier(const XcdBarrier& b) {
    asm volatile("s_waitcnt vmcnt(0)" ::: "memory");
    __syncthreads();
    if (threadIdx.x == 0) {
        unsigned* bar = b.bar;
        __builtin_amdgcn_s_waitcnt(0);
        unsigned nloc = b.st[0], nx = b.st[1];
        if (nloc == 0u) { xcd_barrier_complete(bar, b.x, nloc, nx); b.st[0] = nloc; b.st[1] = nx; }
        const unsigned old = xb_add(&bar[XB_XSUB(b.x)], 1u);
        const unsigned gen = old / nloc;
        if (old + 1u == (gen + 1u) * nloc) {
            __builtin_amdgcn_fence(__ATOMIC_RELEASE, "agent");
            asm volatile("s_waitcnt vmcnt(0)" ::: "memory");
            const unsigned og = xb_add(&bar[XB_TOP], 1u);
            const unsigned tg = og / nx;
            if (og + 1u == (tg + 1u) * nx) xb_add(&bar[XB_TOPGEN], 1u);
            else XB_SPIN(xb_ld(&bar[XB_TOPGEN]) == tg, bar);
            __builtin_amdgcn_fence(__ATOMIC_ACQUIRE, "agent");
            xb_add(&bar[XB_XGEN(b.x)], 1u);
            asm volatile("s_waitcnt vmcnt(0)" ::: "memory");
        } else {
            XB_SPIN(xb_ld(&bar[XB_XGEN(b.x)]) == gen, bar);
            __builtin_amdgcn_fence(__ATOMIC_ACQUIRE, "agent");
            asm volatile("s_waitcnt vmcnt(0)" ::: "memory");
        }
    }
    __syncthreads();
}

enum { EM_SWIGLU = 0, EM_RES = 1, EM_WIN = 2, EM_MULA = 3, EM_GLU = 4, EM_MERGE = 5 };
struct Epi {
    static constexpr bool PERM = true, AFTER_DRAIN = false;
    int mode, variant;
    unsigned char* ws; float* dout; const float* xin; const float* gvec;
    __device__ __forceinline__ void operator()(const f32x4 (&acc)[2][2][4][2], const pg8::Unit& u, int wr, int wc, int fr, int fq) const {
        float* const modp = (float*)(ws + WS_MOD);
        bf16* O = nullptr; int ldc = D; bf16 *O2 = nullptr, *O3 = nullptr, *O4 = nullptr, *O5 = nullptr; const bf16 *P = nullptr, *Q = nullptr;
        const float* base = nullptr; const bf16* baseb = nullptr; float* outf = nullptr; bf16* outb = nullptr; const float* gate = nullptr; float coef = 1.0f;
        const float *rs = nullptr, *tw = nullptr; float* rs_out = nullptr; bf16* XA = nullptr; const float* scn = nullptr;
        if (mode == EM_SWIGLU) { O = (bf16*)(ws + WS_HB); ldc = FF; if (variant) { rs = (const float*)(ws + WS_RS3); tw = (const float*)(ws + WS_TW3); } }
        else if (mode == EM_RES) {
            if (variant == 0) { base = xin; outb = (bf16*)(ws + WS_X1); gate = modp + 2 * D; coef = 0.5f; rs_out = (float*)(ws + WS_RS2); XA = (bf16*)(ws + WS_XN); scn = modp + 4 * D; }
            else if (variant == 1) { baseb = (const bf16*)(ws + WS_X1); outb = (bf16*)dout; gate = modp + 5 * D; coef = 1.0f; rs_out = (float*)(ws + WS_RS3); XA = (bf16*)(ws + WS_XN); scn = modp + 7 * D; }
            else { baseb = (const bf16*)dout; outf = (float*)(ws + WS_X1); gate = modp + 8 * D; coef = 0.5f; }
        } else if (mode == EM_WIN) { rs = (const float*)(ws + WS_RS2); tw = (const float*)(ws + WS_TW2); O = (bf16*)dout + (size_t)M * D; O2 = (bf16*)dout; O3 = (bf16*)(ws + WS_U); O4 = (bf16*)(ws + WS_SA); O5 = (bf16*)(ws + WS_SB); }
        else if (mode == EM_MULA) { O = (bf16*)(ws + WS_SA); P = O; }
        else if (mode == EM_GLU) { O = (bf16*)(ws + WS_S2); P = (const bf16*)(ws + WS_S); ldc = SW; }
        else { O = (bf16*)(ws + WS_SA); P = O; Q = (const bf16*)(ws + WS_SB); }
        const int row0 = u.pm * 256 + wr * 64 + fr;
        const int cw = wc * 32 + 8 * fq;
        if (mode < 0) return;
        f32x4 twv[2][2];
#pragma unroll
        for (int bj = 0; bj < 2; ++bj)
#pragma unroll
            for (int n = 0; n < 2; ++n) twv[bj][n] = (f32x4){0.f, 0.f, 0.f, 0.f};
        if (tw) {
            const float* tp = tw + (size_t)(u.pm >> 3) * NIN + u.pn * 256 + cw;
#pragma unroll
            for (int bj = 0; bj < 2; ++bj)
#pragma unroll
                for (int n = 0; n < 2; ++n) twv[bj][n] = *(const f32x4*)(tp + bj * 128 + 4 * n);
        }
        if (mode == EM_SWIGLU) {
            bf16* bp = O + (size_t)row0 * ldc + u.pn * 128 + cw;
#pragma unroll
            for (int ai = 0; ai < 2; ++ai)
#pragma unroll
                for (int m = 0; m < 4; ++m) {
                    const float rstd = rs ? __builtin_amdgcn_rsqf(rs[row0 + ai * 128 + m * 16] * (1.0f / D) + EPS) : 1.0f;
                    float o[8];
#pragma unroll
                    for (int n = 0; n < 2; ++n)
#pragma unroll
                        for (int j = 0; j < 4; ++j) o[4 * n + j] = fsilu(rstd * acc[ai][0][m][n][j] + twv[0][n][j]) * (rstd * acc[ai][1][m][n][j] + twv[1][n][j]);
                    *(u32x4*)(bp + (size_t)(ai * 128 + m * 16) * ldc) = pack8(o);
                }
        } else if (mode == EM_RES) {
            const int b = u.pm >> 3;
            const float* gp = gate + (size_t)b * NMODC + u.pn * 256 + cw;
            f32x4 gv[2][2];
#pragma unroll
            for (int bj = 0; bj < 2; ++bj)
#pragma unroll
                for (int n = 0; n < 2; ++n) gv[bj][n] = *(const f32x4*)(gp + bj * 128 + 4 * n) * coef;
            f32x4 sv[2][2];
#pragma unroll
            for (int bj = 0; bj < 2; ++bj)
#pragma unroll
                for (int n = 0; n < 2; ++n) sv[bj][n] = (f32x4){0.f, 0.f, 0.f, 0.f};
            if (XA) {
                const float* sp = scn + (size_t)b * NMODC + u.pn * 256 + cw; const float* gq = gvec + u.pn * 256 + cw;
#pragma unroll
                for (int bj = 0; bj < 2; ++bj)
#pragma unroll
                    for (int n = 0; n < 2; ++n) sv[bj][n] = *(const f32x4*)(gq + bj * 128 + 4 * n) * (*(const f32x4*)(sp + bj * 128 + 4 * n) + 1.0f);
            }
#pragma unroll
            for (int ai = 0; ai < 2; ++ai)
#pragma unroll
                for (int m = 0; m < 4; ++m) {
                    const size_t off = (size_t)(row0 + ai * 128 + m * 16) * D + u.pn * 256 + cw;
                    float ss = 0.f;
#pragma unroll
                    for (int bj = 0; bj < 2; ++bj) {
                        f32x4 o[2];
                        if (variant == 0) { o[0] = *(const f32x4*)(base + off + bj * 128); o[1] = *(const f32x4*)(base + off + bj * 128 + 4); }
                        else { float bb[8]; unpack8(*(const u32x4*)(baseb + off + bj * 128), bb); o[0] = (f32x4){bb[0], bb[1], bb[2], bb[3]}; o[1] = (f32x4){bb[4], bb[5], bb[6], bb[7]}; }
#pragma unroll
                        for (int n = 0; n < 2; ++n) {
                            o[n] = o[n] + gv[bj][n] * acc[ai][bj][m][n];
                            ss += (o[n].x * o[n].x + o[n].y * o[n].y) + (o[n].z * o[n].z + o[n].w * o[n].w);
                        }
                        if (variant == 2) { *(f32x4*)(outf + off + bj * 128) = o[0]; *(f32x4*)(outf + off + bj * 128 + 4) = o[1]; }
                        else { u32x4 w; w.x = pk2(o[0].x, o[0].y); w.y = pk2(o[0].z, o[0].w); w.z = pk2(o[1].x, o[1].y); w.w = pk2(o[1].z, o[1].w); *(u32x4*)(outb + off + bj * 128) = w; }
                        if (XA) {
                            const f32x4 a0 = o[0] * sv[bj][0], a1 = o[1] * sv[bj][1];
                            u32x4 w; w.x = pk2(a0.x, a0.y); w.y = pk2(a0.z, a0.w); w.z = pk2(a1.x, a1.y); w.w = pk2(a1.z, a1.w);
                            *(u32x4*)(XA + off + bj * 128) = w;
                        }
                    }
                    if (rs_out) {
                        ss += __shfl_xor(ss, 16); ss += __shfl_xor(ss, 32);
                        if (fq == 0) atomicAdd(rs_out + row0 + ai * 128 + m * 16, ss);
                    }
                    if (m & 1) asm volatile("" ::: "memory");
                }
        } else if (mode == EM_WIN) {
            const int pn = u.pn;
            if (pn >= 4 && pn < 12) {
                bf16* bp = O2 + (size_t)row0 * D + (pn - 4) * 128 + cw;
#pragma unroll
                for (int ai = 0; ai < 2; ++ai)
#pragma unroll
                    for (int m = 0; m < 4; ++m) {
                        const float rstd = rs ? __builtin_amdgcn_rsqf(rs[row0 + ai * 128 + m * 16] * (1.0f / D) + EPS) : 1.0f;
                        float o[8];
#pragma unroll
                        for (int n = 0; n < 2; ++n)
#pragma unroll
                            for (int j = 0; j < 4; ++j) o[4 * n + j] = (rstd * acc[ai][0][m][n][j] + twv[0][n][j]) * (rstd * acc[ai][1][m][n][j] + twv[1][n][j]);
                        *(u32x4*)(bp + (size_t)(ai * 128 + m * 16) * D) = pack8(o);
                    }
            } else {
                bf16* dst; int ld, colt; bool sig;
                if (pn < 4) { dst = O; ld = D; colt = pn * 256; sig = false; }
                else if (pn < 14) { dst = O3; ld = SW; colt = (pn - 12) * 256; sig = false; }
                else if (pn < 18) { dst = O4; ld = D; colt = (pn - 14) * 256; sig = true; }
                else { dst = O5; ld = D; colt = (pn - 18) * 256; sig = true; }
                bf16* bp = dst + (size_t)row0 * ld + colt + cw;
#pragma unroll
                for (int ai = 0; ai < 2; ++ai)
#pragma unroll
                    for (int m = 0; m < 4; ++m) {
                        const float rstd = rs ? __builtin_amdgcn_rsqf(rs[row0 + ai * 128 + m * 16] * (1.0f / D) + EPS) : 1.0f;
#pragma unroll
                        for (int bj = 0; bj < 2; ++bj) {
                            float o[8];
#pragma unroll
                            for (int n = 0; n < 2; ++n)
#pragma unroll
                                for (int j = 0; j < 4; ++j) { const float v = rstd * acc[ai][bj][m][n][j] + twv[bj][n][j]; o[4 * n + j] = sig ? fsigmoid(v) : v; }
                            *(u32x4*)(bp + (size_t)(ai * 128 + m * 16) * ld + bj * 128) = pack8(o);
                        }
                    }
            }
        } else {
            const size_t off0 = (size_t)row0 * ldc + u.pn * 256 + cw;
#pragma unroll
            for (int ai = 0; ai < 2; ++ai)
#pragma unroll
                for (int m = 0; m < 4; ++m) {
#pragma unroll
                    for (int bj = 0; bj < 2; ++bj) {
                        const size_t off = off0 + (size_t)(ai * 128 + m * 16) * ldc + bj * 128;
                        float p[8], q[8], o[8];
                        unpack8(*(const u32x4*)(P + off), p);
                        if (mode == EM_MERGE) unpack8(*(const u32x4*)(Q + off), q);
#pragma unroll
                        for (int n = 0; n < 2; ++n)
#pragma unroll
                            for (int j = 0; j < 4; ++j) {
                                const float v = acc[ai][bj][m][n][j];
                                o[4 * n + j] = (mode == EM_MULA) ? p[4 * n + j] * v : (mode == EM_GLU) ? p[4 * n + j] * fsigmoid(v) : p[4 * n + j] + q[4 * n + j] * v;
                            }
                        *(u32x4*)(O + off) = pack8(o);
                    }
                    if (m & 1) asm volatile("" ::: "memory");
                }
        }
    }
};

__device__ __forceinline__ void tr_item(const float* W, int K, int N, int k0, int n0, bf16* WT, int drow0, LAS float* scr, int lane) {
#pragma unroll 8
    for (int i = 0; i < 32; ++i) { const int kk = 2 * i + (lane >> 5); scr[kk * 33 + (lane & 31)] = W[(size_t)(k0 + kk) * N + n0 + (lane & 31)]; }
    LDS_WAIT();
    const int c = lane & 7;
#pragma unroll
    for (int j = 0; j < 4; ++j) {
        const int n = (lane >> 3) + 8 * j; const LAS float* s = scr + (8 * c) * 33 + n;
        u32x4 o; o.x = pk2(s[0 * 33], s[1 * 33]); o.y = pk2(s[2 * 33], s[3 * 33]); o.z = pk2(s[4 * 33], s[5 * 33]); o.w = pk2(s[6 * 33], s[7 * 33]);
        *(u32x4*)(WT + (size_t)(drow0 + n) * K + k0 + 8 * c) = o;
    }
    LDS_WAIT();
}
enum { MAP_PLAIN = 0, MAP_UP1 = 1, MAP_UP3 = 2, MAP_WIN = 3 };
__device__ __forceinline__ int map_row(int map, int n0) {
    if (map == MAP_PLAIN) return n0;
    if (map == MAP_UP1) return 256 * (n0 >> 7) + (n0 & 127);
    if (map == MAP_UP3) return 256 * (n0 >> 7) + 128 + (n0 & 127);
    if (n0 < 1024 || n0 >= 3072) return n0;
    if (n0 < 2048) { const int cc = n0 - 1024; return 1024 + 256 * (cc >> 7) + (cc & 127); }
    { const int cc = n0 - 2048; return 1024 + 256 * (cc >> 7) + 128 + (cc & 127); }
}

struct Args { const float* in[28]; float* out; unsigned char* ws; int ph_lo, ph_hi; };

__device__ __forceinline__ void prologue(const Args& a, LAS unsigned char* lds, int tid, int lane, int wave, int bid, int G) {
    unsigned char* ws = a.ws;
    { float* rsz = (float*)(ws + WS_RS2); for (int i = bid * NTHR + tid; i < 2 * M; i += G * NTHR) rsz[i] = 0.f; }
    for (int job = bid; job < NMODC / 32; job += G) {
        const int n0 = job * 32, l31 = lane & 31, h5 = lane >> 5;
        f32x16 acc;
#pragma unroll
        for (int r = 0; r < 16; ++r) acc[r] = 0.f;
        const float* cp = a.in[1] + (size_t)l31 * D + wave * 128 + 8 * h5;
        const float* wp = a.in[2] + (size_t)(wave * 128 + 8 * h5) * NMODC + n0 + l31;
#pragma unroll
        for (int kk = 0; kk < 8; ++kk) {
            const f32x4 c0 = *(const f32x4*)(cp + 16 * kk), c1 = *(const f32x4*)(cp + 16 * kk + 4);
            float wv[8];
#pragma unroll
            for (int j = 0; j < 8; ++j) wv[j] = wp[(size_t)(16 * kk + j) * NMODC];
            u32x4 ua, ub;
            ua.x = pk2(c0.x / (1.0f + __expf(-c0.x)), c0.y / (1.0f + __expf(-c0.y))); ua.y = pk2(c0.z / (1.0f + __expf(-c0.z)), c0.w / (1.0f + __expf(-c0.w)));
            ua.z = pk2(c1.x / (1.0f + __expf(-c1.x)), c1.y / (1.0f + __expf(-c1.y))); ua.w = pk2(c1.z / (1.0f + __expf(-c1.z)), c1.w / (1.0f + __expf(-c1.w)));
            ub.x = pk2(wv[0], wv[1]); ub.y = pk2(wv[2], wv[3]); ub.z = pk2(wv[4], wv[5]); ub.w = pk2(wv[6], wv[7]);
            acc = __builtin_amdgcn_mfma_f32_32x32x16_bf16(__builtin_bit_cast(bf16x8, ua), __builtin_bit_cast(bf16x8, ub), acc, 0, 0, 0);
        }
        LAS float* part = (LAS float*)lds;
#pragma unroll
        for (int r = 0; r < 16; ++r) part[(wave * 32 + (r & 3) + 8 * (r >> 2) + 4 * h5) * 32 + l31] = acc[r];
        __syncthreads();
        float* mod = (float*)(ws + WS_MOD);
        for (int o = tid; o < 1024; o += NTHR) {
            const int b = o >> 5, n = o & 31; float sacc = a.in[3][n0 + n];
#pragma unroll
            for (int w8 = 0; w8 < 8; ++w8) sacc += part[(w8 * 32 + b) * 32 + n];
            mod[(size_t)b * NMODC + n0 + n] = sacc;
        }
        __syncthreads();
    }
    if (bid >= G - 4) {
        const int g = (bid - (G - 4)) * 8 + wave, p = lane;
        const float dt = expf(a.in[18][g]);
        const float ar = a.in[12][g * 64 + p], ai = a.in[13][g * 64 + p];
        const float e = expf(ar * dt); float sn, cs; sincosf(ai * dt, &sn, &cs);
        const float abr = e * cs, abi = e * sn;
        const float nr = abr - 1.0f, ni = abi, den = ar * ar + ai * ai;
        const float cr = (nr * ar + ni * ai) / den, ci = (ni * ar - nr * ai) / den;
        float* abar = (float*)(ws + WS_ABAR);
        abar[2 * (g * 64 + p)] = abr; abar[2 * (g * 64 + p) + 1] = abi;
        bf16* Bm = (bf16*)(ws + WS_BMAT);
        unsigned* Cm = (unsigned*)(ws + WS_CMAT);
        float re[16], im[16];
#pragma unroll
        for (int h = 0; h < 16; ++h) { const float br = a.in[14][(size_t)(g * 64 + p) * 16 + h], bi = a.in[15][(size_t)(g * 64 + p) * 16 + h]; re[h] = cr * br - ci * bi; im[h] = cr * bi + ci * br; }
        u32x4* d0 = (u32x4*)(Bm + (size_t)(g * 128 + 2 * p) * 16);
        { u32x4 w0, w1, w2, w3;
          w0.x = pk2(re[0], re[1]); w0.y = pk2(re[2], re[3]); w0.z = pk2(re[4], re[5]); w0.w = pk2(re[6], re[7]);
          w1.x = pk2(re[8], re[9]); w1.y = pk2(re[10], re[11]); w1.z = pk2(re[12], re[13]); w1.w = pk2(re[14], re[15]);
          w2.x = pk2(im[0], im[1]); w2.y = pk2(im[2], im[3]); w2.z = pk2(im[4], im[5]); w2.w = pk2(im[6], im[7]);
          w3.x = pk2(im[8], im[9]); w3.y = pk2(im[10], im[11]); w3.z = pk2(im[12], im[13]); w3.w = pk2(im[14], im[15]);
          d0[0] = w0; d0[1] = w1; d0[2] = w2; d0[3] = w3; }
#pragma unroll
        for (int h = 0; h < 16; ++h) Cm[(size_t)(g * 16 + h) * 64 + p] = pk2(a.in[16][(size_t)(g * 16 + h) * 64 + p], -a.in[17][(size_t)(g * 16 + h) * 64 + p]);
    }
    LAS float* scr = (LAS float*)(lds + wave * 16384);
    const int gw = bid * NWAVES + wave, NGW = G * NWAVES;
#define TRJ(idx, K_, N_, wsoff, MAP_) if (!found) { constexpr int items = ((K_) / 64) * ((N_) / 32); if (r < items) { found = true; W = a.in[idx]; K = (K_); N = (N_); WT = (bf16*)(ws + (wsoff)); map = (MAP_); } else r -= items; }
    constexpr int NITEMS = 2 * (3 * (D / 64) * (FF / 32)) + (D / 64) * (NIN / 32) + 2 * (D / 64) * (D / 32) + (SW / 64) * (SW / 32) + (SW / 64) * (D / 32);
#pragma unroll 1
    for (int it = gw; it < NITEMS; it += NGW) {
        int r = it; bool found = false; const float* W = nullptr; int K = 64, N = 32, map = 0; bf16* WT = nullptr;
        TRJ(5, D, FF, WS_WUPA, MAP_UP1)
        TRJ(6, D, FF, WS_WUPA, MAP_UP3)
        TRJ(7, FF, D, WS_WDNA, MAP_PLAIN)
        TRJ(9, D, NIN, WS_WIN, MAP_WIN)
        TRJ(11, D, D, WS_WC, MAP_PLAIN)
        TRJ(20, SW, SW, WS_WG, MAP_PLAIN)
        TRJ(21, SW, D, WS_WS, MAP_PLAIN)
        TRJ(22, D, D, WS_WO, MAP_PLAIN)
        TRJ(24, D, FF, WS_WUPB, MAP_UP1)
        TRJ(25, D, FF, WS_WUPB, MAP_UP3)
        TRJ(26, FF, D, WS_WDNB, MAP_PLAIN)
        const int nbn = N / 32, kb = r / nbn, nb = r % nbn;
        tr_item(W, K, N, 64 * kb, 32 * nb, WT, map_row(map, 32 * nb), scr, lane);
    }
#undef TRJ
}

__device__ __forceinline__ void tw_jobs(const float* mod, const bf16* Bt0, const bf16* Bt1, float* tw0, float* tw1, LAS unsigned char* lds, int tid, int lane, int wave, int bid, int G) {
    for (int job = bid; job < 2 * (NIN / 32); job += G) {
        const int which = job / (NIN / 32), n0 = (job % (NIN / 32)) * 32, l31 = lane & 31, h5 = lane >> 5;
        const float* tp = mod + (which == 0 ? 3 * D : 6 * D) + (size_t)l31 * NMODC + wave * 128 + 8 * h5;
        const bf16* bp = (which == 0 ? Bt0 : Bt1) + (size_t)(n0 + l31) * D + wave * 128 + 8 * h5;
        float* tw = which == 0 ? tw0 : tw1;
        f32x16 acc;
#pragma unroll
        for (int r = 0; r < 16; ++r) acc[r] = 0.f;
#pragma unroll
        for (int kk = 0; kk < 8; ++kk) {
            const f32x4 c0 = *(const f32x4*)(tp + 16 * kk), c1 = *(const f32x4*)(tp + 16 * kk + 4);
            u32x4 ua; ua.x = pk2(c0.x, c0.y); ua.y = pk2(c0.z, c0.w); ua.z = pk2(c1.x, c1.y); ua.w = pk2(c1.z, c1.w);
            const bf16x8 bfr = *(const bf16x8*)(bp + 16 * kk);
            acc = __builtin_amdgcn_mfma_f32_32x32x16_bf16(__builtin_bit_cast(bf16x8, ua), bfr, acc, 0, 0, 0);
        }
        LAS float* part = (LAS float*)lds;
#pragma unroll
        for (int r = 0; r < 16; ++r) part[(wave * 32 + (r & 3) + 8 * (r >> 2) + 4 * h5) * 32 + l31] = acc[r];
        __syncthreads();
        for (int o = tid; o < 1024; o += NTHR) {
            const int b = o >> 5, n = o & 31; float sacc = 0.f;
#pragma unroll
            for (int w8 = 0; w8 < 8; ++w8) sacc += part[(w8 * 32 + b) * 32 + n];
            tw[(size_t)b * NIN + n0 + n] = sacc;
        }
        __syncthreads();
    }
}

__device__ __forceinline__ void norm_phase(const float* X, const float* gvec, const float* modsh, const float* modsc, bf16* outb, float* outf, int gw, int NGW, int lane) {
    for (int r0 = gw * 32; r0 < M; r0 += NGW * 32) {
        const int b = r0 / SEQ;
        f32x4 scl[4], sft[4];
#pragma unroll
        for (int j = 0; j < 4; ++j) {
            const f32x4 gg = *(const f32x4*)(gvec + 4 * lane + 256 * j);
            if (modsh) { const f32x4 s1 = *(const f32x4*)(modsc + (size_t)b * NMODC + 4 * lane + 256 * j); scl[j] = gg * (s1 + 1.0f); sft[j] = *(const f32x4*)(modsh + (size_t)b * NMODC + 4 * lane + 256 * j); }
            else { scl[j] = gg; sft[j] = (f32x4){0.f, 0.f, 0.f, 0.f}; }
        }
        f32x4 nx[2][4];
#pragma unroll
        for (int q = 0; q < 2; ++q)
#pragma unroll
            for (int j = 0; j < 4; ++j) nx[q][j] = *(const f32x4*)(X + (size_t)(r0 + q) * D + 4 * lane + 256 * j);
#pragma unroll 1
        for (int rr = 0; rr < 32; rr += 2) {
            f32x4 v[2][4];
#pragma unroll
            for (int q = 0; q < 2; ++q)
#pragma unroll
                for (int j = 0; j < 4; ++j) v[q][j] = nx[q][j];
            if (rr + 2 < 32) {
#pragma unroll
                for (int q = 0; q < 2; ++q)
#pragma unroll
                    for (int j = 0; j < 4; ++j) nx[q][j] = *(const f32x4*)(X + (size_t)(r0 + rr + 2 + q) * D + 4 * lane + 256 * j);
            }
#pragma unroll
            for (int q = 0; q < 2; ++q) {
                float sq = 0.f;
#pragma unroll
                for (int j = 0; j < 4; ++j) sq += (v[q][j].x * v[q][j].x + v[q][j].y * v[q][j].y) + (v[q][j].z * v[q][j].z + v[q][j].w * v[q][j].w);
                sq = wave_sum(sq);
                const float rstd = 1.0f / sqrtf(sq * (1.0f / D) + EPS);
                const size_t ro = (size_t)(r0 + rr + q) * D + 4 * lane;
#pragma unroll
                for (int j = 0; j < 4; ++j) {
                    const f32x4 o = v[q][j] * rstd * scl[j] + sft[j];
                    if (outb) { u32x2 w; w.x = pk2(o.x, o.y); w.y = pk2(o.z, o.w); *(u32x2*)(outb + ro + 256 * j) = w; }
                    else *(f32x4*)(outf + ro + 256 * j) = o;
                }
            }
        }
    }
}

__device__ __forceinline__ void ssm_chunk(const bf16x8 Af, int t0, LAS float* Bu, LAS unsigned* Xs, LAS unsigned char* Us, const bf16x8 (&Bf)[4], const bf16x8 (&Cf)[4],
                                          const f32x2 ab, const float dsk, float& xr, float& xi, bf16* Sb, int lane) {
    const int l31 = lane & 31, h5 = lane >> 5, l15 = lane & 15, q4 = lane >> 4;
    *(LAS bf16x8*)(Us + l31 * 32 + h5 * 16) = Af;
#pragma unroll
    for (int nb = 0; nb < 4; ++nb) {
        f32x16 c;
#pragma unroll
        for (int r = 0; r < 16; ++r) c[r] = 0.f;
        c = __builtin_amdgcn_mfma_f32_32x32x16_bf16(Af, Bf[nb], c, 0, 0, 0);
#pragma unroll
        for (int r = 0; r < 16; ++r) Bu[((r & 3) + 8 * (r >> 2) + 4 * h5) * 128 + 32 * nb + l31] = c[r];
    }
    LDS_WAIT();
    f32x2 bu[32];
#pragma unroll
    for (int t = 0; t < 32; ++t) bu[t] = *(const LAS f32x2*)(Bu + t * 128 + 2 * lane);
#pragma unroll
    for (int t = 0; t < 32; ++t) {
        const float nr = __builtin_fmaf(ab.x, xr, __builtin_fmaf(-ab.y, xi, bu[t].x));
        const float ni = __builtin_fmaf(ab.x, xi, __builtin_fmaf(ab.y, xr, bu[t].y));
        xr = nr; xi = ni;
        Xs[t * 68 + lane] = pk2(nr, ni);
    }
    LDS_WAIT();
    f32x4 y[2];
#pragma unroll
    for (int mb = 0; mb < 2; ++mb) {
        y[mb] = (f32x4){0.f, 0.f, 0.f, 0.f};
#pragma unroll
        for (int kb = 0; kb < 4; ++kb) {
            const bf16x8 xa = *(const LAS bf16x8*)((const LAS unsigned char*)Xs + (16 * mb + l15) * 272 + (32 * kb + 8 * q4) * 2);
            y[mb] = __builtin_amdgcn_mfma_f32_16x16x32_bf16(xa, Cf[kb], y[mb], 0, 0, 0);
        }
    }
#pragma unroll
    for (int mb = 0; mb < 2; ++mb)
#pragma unroll
        for (int r = 0; r < 4; ++r) {
            const int t = 16 * mb + 4 * q4 + r;
            const float u = bf2f(*(const LAS bf16*)(Us + t * 32 + l15 * 2));
            const float sv = y[mb][r] + dsk * u;
            Sb[(size_t)(t0 + t) * SW + l15] = (bf16)(pk2(fgelu_tanh(sv), 0.f) & 0xffffu);
        }
    LDS_WAIT();
}
__device__ __forceinline__ void ssm_job(int job, LAS unsigned char* wl, const bf16* U, bf16* S, const float* abar, const bf16* Bmat, const bf16* CmT, const float* dskip, int lane) {
    const int b = job >> 5, g = job & 31;
    const int l31 = lane & 31, h5 = lane >> 5, l15 = lane & 15, q4 = lane >> 4;
    bf16x8 Bf[4], Cf[4];
#pragma unroll
    for (int nb = 0; nb < 4; ++nb) Bf[nb] = *(const bf16x8*)(Bmat + ((size_t)(g * 128 + 32 * nb + l31) * 16 + 8 * h5));
#pragma unroll
    for (int kb = 0; kb < 4; ++kb) Cf[kb] = *(const bf16x8*)(CmT + ((size_t)(g * 16 + l15) * 128 + 32 * kb + 8 * q4));
    const f32x2 ab = *(const f32x2*)(abar + 2 * (g * 64 + lane));
    const float dsk = dskip[16 * g + l15];
    float xr = 0.f, xi = 0.f;
    LAS float* Bu = (LAS float*)wl;
    LAS unsigned* Xs = (LAS unsigned*)(wl + 16384);
    LAS unsigned char* Us = wl + 16384 + 8704;
    const bf16* Ub = U + (size_t)b * SEQ * SW + 16 * g + (size_t)l31 * SW + 8 * h5;
    bf16* Sb = S + (size_t)b * SEQ * SW + 16 * g;
    bf16x8 nxt[4];
#pragma unroll
    for (int c = 0; c < 4; ++c) nxt[c] = *(const bf16x8*)(Ub + (size_t)(32 * c) * SW);
#pragma unroll 1
    for (int grp = 0; grp < SEQ / 128; ++grp) {
        const int t0 = grp * 128;
        bf16x8 cur[4];
#pragma unroll
        for (int c = 0; c < 4; ++c) cur[c] = nxt[c];
        ssm_chunk(cur[0], t0, Bu, Xs, Us, Bf, Cf, ab, dsk, xr, xi, Sb, lane);
        if (grp + 1 < SEQ / 128) {
#pragma unroll
            for (int c = 0; c < 4; ++c) nxt[c] = *(const bf16x8*)(Ub + (size_t)(t0 + 128 + 32 * c) * SW);
        }
        ssm_chunk(cur[1], t0 + 32, Bu, Xs, Us, Bf, Cf, ab, dsk, xr, xi, Sb, lane);
        ssm_chunk(cur[2], t0 + 64, Bu, Xs, Us, Bf, Cf, ab, dsk, xr, xi, Sb, lane);
        ssm_chunk(cur[3], t0 + 96, Bu, Xs, Us, Bf, Cf, ab, dsk, xr, xi, Sb, lane);
    }
}

__device__ __forceinline__ void conv_job(int j, const bf16* Z, const bf16* GB, bf16* YA, const float* cwt, int lane) {
    const int b = j >> 7, rem = j & 127, tb = rem >> 1, half = rem & 1;
    const int col = half * 512 + lane * 8;
    float w0[8], w1[8], w2[8];
#pragma unroll
    for (int i = 0; i < 8; ++i) { w0[i] = cwt[col + i]; w1[i] = cwt[D + col + i]; w2[i] = cwt[2 * D + col + i]; }
    const size_t rowbase = (size_t)b * SEQ + tb * 32;
    float z2[8], z1[8];
#pragma unroll
    for (int i = 0; i < 8; ++i) { z2[i] = 0.f; z1[i] = 0.f; }
    if (tb > 0) { unpack8(*(const u32x4*)(Z + (rowbase - 2) * D + col), z2); unpack8(*(const u32x4*)(Z + (rowbase - 1) * D + col), z1); }
#pragma unroll 1
    for (int t = 0; t < 32; t += 8) {
        u32x4 zr[8], gr[8];
#pragma unroll
        for (int q = 0; q < 8; ++q) { zr[q] = *(const u32x4*)(Z + (rowbase + t + q) * D + col); gr[q] = *(const u32x4*)(GB + (rowbase + t + q) * D + col); }
#pragma unroll
        for (int q = 0; q < 8; ++q) {
            float zc[8], gb[8], o[8];
            unpack8(zr[q], zc); unpack8(gr[q], gb);
#pragma unroll
            for (int i = 0; i < 8; ++i) { o[i] = gb[i] * (w0[i] * z2[i] + w1[i] * z1[i] + w2[i] * zc[i]); z2[i] = z1[i]; z1[i] = zc[i]; }
            *(u32x4*)(YA + (rowbase + t + q) * D + col) = pack8(o);
        }
        asm volatile("" ::: "memory");
    }
}

#ifndef REPEAT_PH
#define REPEAT_PH -1
#endif
#ifndef PROBE_A
#define PROBE_A -1
#define PROBE_B -1
#endif
constexpr int NPH = 15;
__global__ void __launch_bounds__(NTHR, 2) fwd_kernel(Args a) {
    extern __shared__ __attribute__((aligned(16))) unsigned char lds_raw[];
    LAS unsigned char* lds = (LAS unsigned char*)lds_raw;
    const int tid0 = threadIdx.x;
    const int G = gridDim.x, bid0 = blockIdx.x;
    unsigned char* ws0 = a.ws;
    volatile LAS unsigned* MISC = (volatile LAS unsigned*)(lds + 131072 + 320);
    if (tid0 < 32) MISC[tid0] = 0u;
    __syncthreads();
    const XcdBarrier xbar = xcd_barrier_post((unsigned*)(ws0 + WS_BAR), MISC + 8);

    bool repeated = false; (void)repeated;
#pragma unroll 1
    for (int ph = a.ph_lo; ph < a.ph_hi; ++ph) {
        int tid = tid0, bid = bid0; __attribute__((address_space(1))) unsigned char* wsg = (__attribute__((address_space(1))) unsigned char*)ws0;
        asm volatile("" : "+v"(tid)); asm volatile("" : "+s"(bid)); asm volatile("" : "+s"(wsg));
        unsigned char* ws = (unsigned char*)wsg;
        const int lane = tid & 63, wave = __builtin_amdgcn_readfirstlane(tid >> 6);
        const int gw = bid * NWAVES + wave, NGW = G * NWAVES;
        float* mod = (float*)(ws + WS_MOD);
        float* X1 = (float*)(ws + WS_X1);
        float* X2 = a.out;
        bf16* XN = (bf16*)(ws + WS_XN); bf16* HB = (bf16*)(ws + WS_HB);
        bf16* Zb = (bf16*)a.out; bf16* GBb = (bf16*)a.out + (size_t)M * D;
        bf16* Ub = (bf16*)(ws + WS_U); bf16* SAb = (bf16*)(ws + WS_SA); bf16* SBb = (bf16*)(ws + WS_SB);
        bf16* Sb = (bf16*)(ws + WS_S); bf16* S2b = (bf16*)(ws + WS_S2); bf16* YAb = (bf16*)(ws + WS_YA);
#if PROBE_A >= 0
        if (bid == 0 && tid == 0) ((unsigned long long*)(ws + 65536))[ph] = __builtin_amdgcn_s_memrealtime();
#endif
        bool is_gemm = false, sync_after = true;
        pg8::Gemm g{nullptr, nullptr, M, 0, 0};
        Epi E{}; E.ws = ws; E.dout = a.out; E.xin = a.in[0];
        switch (ph) {
        case 0: prologue(a, lds, tid, lane, wave, bid, G); break;
        case 1: tw_jobs(mod, (const bf16*)(ws + WS_WIN), (const bf16*)(ws + WS_WUPB), (float*)(ws + WS_TW2), (float*)(ws + WS_TW3), lds, tid, lane, wave, bid, G);
                norm_phase(a.in[0], a.in[4], mod + 0 * D, mod + 1 * D, XN, nullptr, gw, NGW, lane); break;
        case 2: is_gemm = true; g.A = XN; g.Bt = (const bf16*)(ws + WS_WUPA); g.N = NUP; g.K = D; E.mode = EM_SWIGLU; E.variant = 0; break;
        case 3: is_gemm = true; g.A = HB; g.Bt = (const bf16*)(ws + WS_WDNA); g.N = D; g.K = FF; E.mode = EM_RES; E.variant = 0; E.gvec = a.in[8]; break;
        case 4: sync_after = false; break;
        case 5: is_gemm = true; g.A = XN; g.Bt = (const bf16*)(ws + WS_WIN); g.N = NIN; g.K = D; E.mode = EM_WIN; break;
        case 6: {
            if (wave < 4) {
#if defined(PROBE_SKIP_SSM)
                if (repeated)
#endif
                for (int job = bid * 4 + wave; job < BATCH * 32; job += G * 4)
                    ssm_job(job, lds + wave * 32768, Ub, Sb, (const float*)(ws + WS_ABAR), (const bf16*)(ws + WS_BMAT), (const bf16*)(ws + WS_CMAT), a.in[19], lane);
            } else {
                for (int j = bid * 4 + (wave - 4); j < BATCH * 128; j += G * 4) conv_job(j, Zb, GBb, YAb, a.in[10], lane);
            }
        } break;
        case 7: is_gemm = true; sync_after = false; g.A = YAb; g.Bt = (const bf16*)(ws + WS_WC); g.N = D; g.K = D; E.mode = EM_MULA; break;
        case 8: is_gemm = true; g.A = Sb; g.Bt = (const bf16*)(ws + WS_WG); g.N = SW; g.K = SW; E.mode = EM_GLU; break;
        case 9: is_gemm = true; g.A = S2b; g.Bt = (const bf16*)(ws + WS_WS); g.N = D; g.K = SW; E.mode = EM_MERGE; break;
        case 10: is_gemm = true; g.A = SAb; g.Bt = (const bf16*)(ws + WS_WO); g.N = D; g.K = D; E.mode = EM_RES; E.variant = 1; E.gvec = a.in[23]; break;
        case 11: sync_after = false; break;
        case 12: is_gemm = true; g.A = XN; g.Bt = (const bf16*)(ws + WS_WUPB); g.N = NUP; g.K = D; E.mode = EM_SWIGLU; E.variant = 1; break;
        case 13: is_gemm = true; g.A = HB; g.Bt = (const bf16*)(ws + WS_WDNB); g.N = D; g.K = FF; E.mode = EM_RES; E.variant = 2; break;
        case 14: norm_phase(X1, a.in[27], nullptr, nullptr, nullptr, a.out, gw, NGW, lane); break;
#if PROBE_A >= 0
        case 15: {
            const unsigned long long* ts = (const unsigned long long*)(ws + 65536);
            const float e1 = (float)(ts[PROBE_A + 1] - ts[PROBE_A]) * 1e-4f, e2 = (float)(ts[PROBE_B + 1] - ts[PROBE_B]) * 1e-5f;
            for (size_t i = (size_t)bid * NTHR + tid; i < (size_t)(1u << 22); i += (size_t)G * NTHR) a.out[i] += e2;
            if (bid == 0 && tid == 0) a.out[(1u << 22) + 5] += e1;
        } break;
#endif
        default: break;
        }
        if (is_gemm) {
#if REPEAT_PH >= 0
            if (ph == REPEAT_PH && !repeated) E.mode = -1;
#endif
            pg8::StaticOrder S; S.init(g.M, g.N, G, bid);
            pg8::gemm_phase<Epi, pg8::StaticOrder, true, true>(lds, g, S, E);
        }
        if (ph + 1 < a.ph_hi && sync_after) { if (a.ph_hi > 1000) cg::this_grid().sync(); else xcd_barrier(xbar); }
#if REPEAT_PH >= 0
        if (ph == REPEAT_PH && !repeated) { repeated = true; if (!sync_after || ph + 1 >= a.ph_hi) cg::this_grid().sync(); --ph; }
#endif
    }
}

#ifndef MK_MULTI
#define MK_MULTI 0
#endif
extern "C" void kernel_launch(void* const* d_in, const int* in_sizes, int n_in, void* d_out, int out_size, void* d_ws, size_t ws_size, hipStream_t stream) {
    static int grid = 0;
    if (grid == 0) {
        if (n_in != 28 || in_sizes[0] != M * D || out_size != M * D || ws_size < WS_END) { fprintf(stderr, "kernel_launch: unexpected shapes (n_in %d, in0 %d, out %d, ws %zu)\n", n_in, n_in > 0 ? in_sizes[0] : -1, out_size, ws_size); grid = -1; return; }
        int dev = 0, cus = 0, per_cu = 0;
        if (hipGetDevice(&dev) != hipSuccess || hipDeviceGetAttribute(&cus, hipDeviceAttributeMultiprocessorCount, dev) != hipSuccess) { grid = -1; return; }
        if (hipFuncSetAttribute((const void*)fwd_kernel, hipFuncAttributeMaxDynamicSharedMemorySize, LDS_BYTES) != hipSuccess) { fprintf(stderr, "kernel_launch: hipFuncSetAttribute failed\n"); grid = -1; return; }
        if (hipOccupancyMaxActiveBlocksPerMultiprocessor(&per_cu, (const void*)fwd_kernel, NTHR, LDS_BYTES) != hipSuccess || per_cu < 1) { fprintf(stderr, "kernel_launch: occupancy query says %d\n", per_cu); per_cu = 1; }
        (void)hipGetLastError();
        grid = cus * per_cu;
        fprintf(stderr, "kernel_launch: grid %d (cus %d x %d)\n", grid, cus, per_cu);
    }
    if (grid < 0) return;
    if (hipMemsetAsync((char*)d_ws + WS_BAR, 0, WS_BAR_BYTES, stream) != hipSuccess) { fprintf(stderr, "kernel_launch: memset failed\n"); return; }
    Args a{};
    for (int i = 0; i < 28; ++i) a.in[i] = (const float*)d_in[i];
    a.out = (float*)d_out; a.ws = (unsigned char*)d_ws;
#if MK_MULTI
    for (int ph = 0; ph < NPH; ++ph) { a.ph_lo = ph; a.ph_hi = ph + 1; hipLaunchKernelGGL(fwd_kernel, dim3(grid), dim3(NTHR), LDS_BYTES, stream, a); }
#else
    a.ph_lo = 0; a.ph_hi = NPH + (PROBE_A >= 0 ? 1 : 0);
    void* kargs[] = {(void*)&a};
    hipError_t e = hipLaunchCooperativeKernel((const void*)fwd_kernel, dim3(grid), dim3(NTHR), kargs, LDS_BYTES, stream);
    if (e != hipSuccess) fprintf(stderr, "kernel_launch: cooperative launch failed: %s (grid %d)\n", hipGetErrorString(e), grid);
#endif
}
```
